# Optimizing an MI355X kernel written in HIP

```python
import jax, jax.numpy as jnp
from jax import lax
import numpy as np

D_MODEL = 2048
BATCH = 1
SEQ = 8192
DEPTH = 4

HEAD_DIM = 128
D_MIX = D_MODEL
N_MIX_HEADS = D_MIX // HEAD_DIM
N_GMLP_GROUPS = N_MIX_HEADS // 4
N_RET_HEADS = (N_MIX_HEADS - N_GMLP_GROUPS) // 2
N_MLA_HEADS = N_MIX_HEADS - N_GMLP_GROUPS - N_RET_HEADS
RET_WIDTH = N_RET_HEADS * HEAD_DIM
MLA_WIDTH = N_MLA_HEADS * HEAD_DIM
GMLP_WIDTH = N_GMLP_GROUPS * HEAD_DIM

Q_LORA_RANK = D_MODEL // 4
KV_LORA_RANK = 512
QK_NOPE_DIM = 128
QK_ROPE_DIM = 64
V_HEAD_DIM = HEAD_DIM
QK_HEAD_DIM = QK_NOPE_DIM + QK_ROPE_DIM

CHUNK = 128
BLOCK_Q = 128
D_FF = ((8 * D_MODEL // 3 + 255) // 256) * 256
ROPE_BASE = 10000.0
EPS = 1e-6

IN_SIZES = [RET_WIDTH, RET_WIDTH, RET_WIDTH, RET_WIDTH,
            Q_LORA_RANK, KV_LORA_RANK, QK_ROPE_DIM,
            GMLP_WIDTH, GMLP_WIDTH]
IN_SPLITS = [int(s) for s in np.cumsum(IN_SIZES)[:-1]]
D_IN = int(sum(IN_SIZES))

kernel_name = "hybrid_retention_mla_gmlp_swiglu"


def rms_norm(x, gain):
    xf = x.astype(jnp.float32)
    y = xf * lax.rsqrt(jnp.mean(xf * xf, axis=-1, keepdims=True) + EPS)
    return (y * gain.astype(jnp.float32)).astype(x.dtype)


def rope_tables(positions, dim):
    inv = 1.0 / (ROPE_BASE ** (jnp.arange(0, dim, 2, dtype=jnp.float32) / dim))
    ang = positions.astype(jnp.float32)[..., None] * inv
    return jnp.cos(ang)[:, :, None, :], jnp.sin(ang)[:, :, None, :]


def apply_rope(x, cos, sin):
    x1, x2 = jnp.split(x.astype(jnp.float32), 2, axis=-1)
    return jnp.concatenate([x1 * cos - x2 * sin, x2 * cos + x1 * sin], axis=-1).astype(x.dtype)


def retention(q, k, v):
    B, S, H, Dh = q.shape
    n = S // CHUNK
    log_gamma = jnp.log1p(-jnp.exp2(-5.0 - jnp.arange(H, dtype=jnp.float32)))
    idx = jnp.arange(CHUNK, dtype=jnp.float32)
    rel = idx[:, None] - idx[None, :]
    inner_decay = jnp.where(rel >= 0, jnp.exp(log_gamma[:, None, None] * jnp.maximum(rel, 0.0)), 0.0)
    q_decay = jnp.exp(log_gamma[None, :] * (idx[:, None] + 1.0))
    k_decay = jnp.exp(log_gamma[None, :] * (CHUNK - 1.0 - idx[:, None]))
    chunk_decay = jnp.exp(log_gamma * CHUNK)
    qc = q.reshape(B, n, CHUNK, H, Dh)
    kc = k.reshape(B, n, CHUNK, H, Dh) * (Dh ** -0.5)
    vc = v.reshape(B, n, CHUNK, H, Dh)
    scores = jnp.einsum('bnihd,bnjhd->bnhij', qc, kc) * inner_decay.astype(q.dtype)
    inner = jnp.einsum('bnhij,bnjhd->bnihd', scores, vc)
    kv = jnp.einsum('bnjhd,bnjhe->bnhde', kc * k_decay[:, :, None].astype(k.dtype), vc).astype(jnp.float32)

    def step(state, kv_n):
        return chunk_decay[None, :, None, None] * state + kv_n, state

    _, prev = lax.scan(step, jnp.zeros((B, H, Dh, Dh), jnp.float32), jnp.moveaxis(kv, 1, 0))
    prev = jnp.moveaxis(prev, 0, 1).astype(q.dtype)
    cross = jnp.einsum('bnihd,bnhde->bnihe', qc * q_decay[:, :, None].astype(q.dtype), prev)
    return (inner + cross).reshape(B, S, H, Dh)


def causal_block_attention(q, k, v):
    B, S, H, Dqk = q.shape
    Dv = v.shape[-1]
    nb = S // BLOCK_Q
    scale = Dqk ** -0.5
    qb = jnp.moveaxis(q.reshape(B, nb, BLOCK_Q, H, Dqk), 1, 0)
    k_pos = jnp.arange(S)

    def one_block(args):
        i, q_blk = args
        s = jnp.einsum('bqhd,bkhd->bhqk', q_blk, k).astype(jnp.float32) * scale
        q_pos = i * BLOCK_Q + jnp.arange(BLOCK_Q)
        s = jnp.where(k_pos[None, :] <= q_pos[:, None], s, -jnp.inf)
        p = jax.nn.softmax(s, axis=-1).astype(v.dtype)
        return jnp.einsum('bhqk,bkhd->bqhd', p, v)

    out = lax.map(one_block, (jnp.arange(nb), qb))
    return jnp.moveaxis(out, 0, 1).reshape(B, S, H, Dv)


def chunked_spatial_gating(u, v, v_gain, w_s, b_s):
    B, S, G, Dg = v.shape
    n = S // CHUNK
    v = rms_norm(v, v_gain.reshape(G, Dg))
    mask = jnp.tril(jnp.ones((CHUNK, CHUNK), dtype=bool))
    w = jnp.where(mask[None], w_s, 0.0).astype(v.dtype)
    vc = v.reshape(B, n, CHUNK, G, Dg)
    s = jnp.einsum('gts,bnsgc->bntgc', w, vc) + b_s.T[None, None, :, :, None].astype(v.dtype)
    return u * s.reshape(B, S, G, Dg)


def hybrid_layer(x, rope_ret, rope_mla, attn_norm, w_in, mla_q_norm, w_uq, mla_kv_norm, w_ukv,
                 gmlp_v_norm, gmlp_w_s, gmlp_b_s, mix_norm, w_out, ffn_norm, w_gate, w_up, w_down):
    B, S, _ = x.shape
    h = rms_norm(x, attn_norm)
    z = h @ w_in
    r_q, r_k, r_v, r_g, c_q, c_kv, k_pe, g_u, g_v = jnp.split(z, IN_SPLITS, axis=-1)

    cos_r, sin_r = rope_ret
    rq = apply_rope(r_q.reshape(B, S, N_RET_HEADS, HEAD_DIM), cos_r, sin_r)
    rk = apply_rope(r_k.reshape(B, S, N_RET_HEADS, HEAD_DIM), cos_r, sin_r)
    y_ret = retention(rq, rk, r_v.reshape(B, S, N_RET_HEADS, HEAD_DIM))

    cos_m, sin_m = rope_mla
    mq = (rms_norm(c_q, mla_q_norm) @ w_uq).reshape(B, S, N_MLA_HEADS, QK_HEAD_DIM)
    q_nope, q_pe = jnp.split(mq, [QK_NOPE_DIM], axis=-1)
    mq = jnp.concatenate([q_nope, apply_rope(q_pe, cos_m, sin_m)], axis=-1)
    mkv = (rms_norm(c_kv, mla_kv_norm) @ w_ukv).reshape(B, S, N_MLA_HEADS, QK_NOPE_DIM + V_HEAD_DIM)
    k_nope, mv = jnp.split(mkv, [QK_NOPE_DIM], axis=-1)
    k_pe = apply_rope(k_pe.reshape(B, S, 1, QK_ROPE_DIM), cos_m, sin_m)
    mk = jnp.concatenate([k_nope, jnp.broadcast_to(k_pe, (B, S, N_MLA_HEADS, QK_ROPE_DIM))], axis=-1)
    y_mla = causal_block_attention(mq, mk, mv)

    gu = jax.nn.gelu(g_u).reshape(B, S, N_GMLP_GROUPS, HEAD_DIM)
    gv = jax.nn.gelu(g_v).reshape(B, S, N_GMLP_GROUPS, HEAD_DIM)
    y_gm = chunked_spatial_gating(gu, gv, gmlp_v_norm, gmlp_w_s, gmlp_b_s)

    y = jnp.concatenate([y_ret, y_mla, y_gm], axis=2)
    y = rms_norm(y, mix_norm.reshape(N_MIX_HEADS, HEAD_DIM)).reshape(B, S, D_MIX)
    y = jnp.concatenate([y[..., :RET_WIDTH] * jax.nn.silu(r_g), y[..., RET_WIDTH:]], axis=-1)
    x = x + y @ w_out

    h = rms_norm(x, ffn_norm)
    return x + (jax.nn.silu(h @ w_gate) * (h @ w_up)) @ w_down


def setup_inputs(seed: int = 0) -> dict:
    key = jax.random.key(seed)
    ks = jax.random.split(key, 20)
    f32 = jnp.float32

    def w(k, shape, fan_in):
        return jax.random.normal(k, shape, f32) * (fan_in ** -0.5)

    def gain(k, shape):
        return 1.0 + 0.02 * jax.random.normal(k, shape, f32)

    L = DEPTH
    tri = jnp.tril(jnp.ones((CHUNK, CHUNK), f32))
    w_s = jax.random.normal(ks[10], (L, N_GMLP_GROUPS, CHUNK, CHUNK), f32) * (CHUNK ** -0.5) * tri
    return {
        "x": jax.random.normal(ks[0], (BATCH, SEQ, D_MODEL), f32),
        "positions": jnp.broadcast_to(jnp.arange(SEQ, dtype=jnp.int32), (BATCH, SEQ)),
        "attn_norm": gain(ks[1], (L, D_MODEL)),
        "w_in": w(ks[2], (L, D_MODEL, D_IN), D_MODEL),
        "mla_q_norm": gain(ks[3], (L, Q_LORA_RANK)),
        "w_uq": w(ks[4], (L, Q_LORA_RANK, N_MLA_HEADS * QK_HEAD_DIM), Q_LORA_RANK),
        "mla_kv_norm": gain(ks[5], (L, KV_LORA_RANK)),
        "w_ukv": w(ks[6], (L, KV_LORA_RANK, N_MLA_HEADS * (QK_NOPE_DIM + V_HEAD_DIM)), KV_LORA_RANK),
        "gmlp_v_norm": gain(ks[7], (L, GMLP_WIDTH)),
        "gmlp_w_s": w_s,
        "gmlp_b_s": 1.0 + 0.02 * jax.random.normal(ks[11], (L, N_GMLP_GROUPS, CHUNK), f32),
        "mix_norm": gain(ks[12], (L, D_MIX)),
        "w_out": w(ks[13], (L, D_MIX, D_MODEL), D_MIX),
        "ffn_norm": gain(ks[14], (L, D_MODEL)),
        "w_gate": w(ks[15], (L, D_MODEL, D_FF), D_MODEL),
        "w_up": w(ks[16], (L, D_MODEL, D_FF), D_MODEL),
        "w_down": w(ks[17], (L, D_FF, D_MODEL), D_FF),
        "final_norm": gain(ks[18], (D_MODEL,)),
    }


def reference(x, positions, attn_norm, w_in, mla_q_norm, w_uq, mla_kv_norm, w_ukv, gmlp_v_norm,
              gmlp_w_s, gmlp_b_s, mix_norm, w_out, ffn_norm, w_gate, w_up, w_down, final_norm):
    rope_ret = rope_tables(positions, HEAD_DIM)
    rope_mla = rope_tables(positions, QK_ROPE_DIM)
    for l in range(DEPTH):
        x = hybrid_layer(x, rope_ret, rope_mla, attn_norm[l], w_in[l], mla_q_norm[l], w_uq[l],
                         mla_kv_norm[l], w_ukv[l], gmlp_v_norm[l], gmlp_w_s[l], gmlp_b_s[l],
                         mix_norm[l], w_out[l], ffn_norm[l], w_gate[l], w_up[l], w_down[l])
    return rms_norm(x, final_norm)
```

```cpp
#include <hip/hip_runtime.h>
#include <hip/hip_cooperative_groups.h>
#include <cstdint>
#include <cstdio>
namespace cg = cooperative_groups;

#define LAS __attribute__((address_space(3)))
#define DI __device__ __forceinline__
typedef unsigned short bf16_t;
typedef short bf16x8 __attribute__((ext_vector_type(8)));
typedef short s16x4 __attribute__((ext_vector_type(4)));
typedef float f32x4 __attribute__((ext_vector_type(4)));
typedef float f32x16 __attribute__((ext_vector_type(16)));
typedef unsigned u32x4 __attribute__((ext_vector_type(4)));
typedef unsigned u32x2 __attribute__((ext_vector_type(2)));

constexpr int S = 8192, DM = 2048, NL = 4, DIN = 5184, DINP = 5376, DFF = 5632, NQ = 1280, NKV = 768;
constexpr int Z_RQ = 0, Z_RK = 768, Z_RV = 1536, Z_RG = 2304, Z_CQ = 3072, Z_CKV = 3584, Z_GU = 4096, Z_GV = 4608, Z_KPE = 5120;
constexpr float EPS = 1e-6f;
constexpr float QSCALE = 0.07216878364870322f * 1.4426950408889634f;
constexpr float KSCALE_RET = 0.08838834764831845f;

constexpr size_t MiB = 1u << 20;
constexpr size_t WS_SSQ = 0;
constexpr size_t WS_COSR = 1 * MiB, WS_SINR = 3 * MiB, WS_COSM = 5 * MiB, WS_SINM = 6 * MiB;
constexpr size_t WS_W = 8 * MiB, W_LAYER = 98 * MiB;
constexpr size_t WO_IN = 0, WO_UQ = 21 * MiB, WO_K = 21 * MiB + 1280 * 1024, WO_V = WO_K + 768 * 1024, WO_OUT = 23 * MiB + 768 * 1024, WO_GU = WO_OUT + 8 * MiB, WO_DN = WO_GU + 44 * MiB;
static_assert(WO_DN + 22 * MiB <= W_LAYER, "weights layer");
constexpr size_t WS_XRES = WS_W + 4 * W_LAYER;
constexpr size_t WS_XB = WS_XRES + 64 * MiB;
constexpr size_t WS_Z = WS_XB + 32 * MiB;
constexpr size_t WS_MQ = WS_Z + 84 * MiB;
constexpr size_t WS_HID = WS_Z;
constexpr size_t WS_KN = WS_MQ + 20 * MiB;
constexpr size_t WS_VT = WS_KN + 12 * MiB;
constexpr size_t WS_Y = WS_VT + 12 * MiB;
constexpr size_t WS_KVT = WS_Y + 32 * MiB;
constexpr size_t WS_PREVT = WS_KVT + 24 * MiB;
constexpr size_t WS_PATTN = WS_PREVT + 12 * MiB;
constexpr size_t WS_PFFN = WS_PATTN + 1 * MiB;
constexpr size_t WS_PCQ = WS_PFFN + 1 * MiB;
constexpr size_t WS_PCKV = WS_PCQ + 1 * MiB;
constexpr size_t WS_APART = WS_PCKV + 1 * MiB;
constexpr size_t APART_REC = 8 * 34 * 64;
constexpr size_t WS_END = WS_APART + 56 * MiB;
static_assert((size_t)S * DFF * 2 <= 104 * MiB, "hid overlay");
static_assert(432 * APART_REC * 4 <= 56 * MiB, "attention partials");

constexpr int LDS_BYTES = 147456;

struct Params {
    const float* x; const int* pos; const float* attn_norm; const float* w_in; const float* q_norm; const float* w_uq; const float* kv_norm; const float* w_ukv;
    const float* gv_norm; const float* w_s; const float* b_s; const float* mix_norm; const float* w_out; const float* ffn_norm; const float* w_gate; const float* w_up;
    const float* w_down; const float* final_norm; float* out; unsigned char* ws;
};

DI unsigned f2bf(float f) { unsigned u = __builtin_bit_cast(unsigned, f); return (u + 0x7fffu + ((u >> 16) & 1u)) >> 16; }
typedef float f32x2_t __attribute__((ext_vector_type(2))); typedef __bf16 bf16x2_t __attribute__((ext_vector_type(2)));
DI unsigned pk2(float lo, float hi) { const f32x2_t v = {lo, hi}; const bf16x2_t b = __builtin_convertvector(v, bf16x2_t); return __builtin_bit_cast(unsigned, b); }
DI float half_max(float m) { auto rr = __builtin_amdgcn_permlane32_swap(__float_as_uint(m), __float_as_uint(m), false, false); return fmaxf(__uint_as_float(rr[0]), __uint_as_float(rr[1])); }
DI float half_sum(float m) { auto rr = __builtin_amdgcn_permlane32_swap(__float_as_uint(m), __float_as_uint(m), false, false); return __uint_as_float(rr[0]) + __uint_as_float(rr[1]); }
DI float bf2f(unsigned short b) { return __builtin_bit_cast(float, (unsigned)b << 16); }
DI float bflo(unsigned w) { return __builtin_bit_cast(float, w << 16); }
DI float bfhi(unsigned w) { return __builtin_bit_cast(float, w & 0xffff0000u); }
DI float gelu_tanh(float x) { const float u = 0.7978845608028654f * (x + 0.044715f * x * x * x); const float e = __builtin_amdgcn_exp2f(2.885390081777927f * u); const float t = 1.f - 2.f * __builtin_amdgcn_rcpf(e + 1.f); return 0.5f * x * (1.f + t); }
DI float silu(float x) { return x * __builtin_amdgcn_rcpf(1.f + __builtin_amdgcn_exp2f(-1.4426950408889634f * x)); }
DI int tid_opaque() { int t = threadIdx.x; asm volatile("" : "+v"(t)); return t; }
DI int sgpr_opaque(int v) { asm volatile("" : "+s"(v)); return v; }

namespace pg8 {
constexpr int BM = 256, BK = 64, HALF = 128, HTB = HALF * BK * 2, STAGE_BYTES = 8 * HTB, NXCD = 8, WGM = 8;
__host__ __device__ __forceinline__ int lds_byte(int r, int c) { const int st = (r >> 4) * 2 + (c >> 5), rr = r & 15, cc = c & 31, ob = rr * 64 + cc * 2; return st * 1024 + (ob ^ (((ob >> 9) & 1) << 5)); }
__host__ __device__ __forceinline__ void stage_rc(int b, int& R, int& C) { const int st = b / 1024, sb = b % 1024, swz = sb ^ (((sb >> 9) & 1) << 5); R = (st >> 1) * 16 + swz / 64; C = (st & 1) * 32 + (swz % 64) / 2; }
__host__ __device__ __forceinline__ int perm32(int rho) { const int n = rho >> 4, i = rho & 15; return 8 * (i >> 2) + 4 * n + (i & 3); }
struct Unit { int pm, pn; };
struct Gemm { const bf16_t* A; const bf16_t* Bt; int M, N, K, lda, ldb; };
struct StaticOrder {
    int nM, nN, nwg, G, c;
    __device__ void init(int M, int N, int G_, int c_) { nM = M / BM; nN = N / BM; nwg = nM * nN; G = G_; c = c_; }
    __device__ bool next(int i, Unit& u) const {
        const long L = (long)i * G + c; if (L >= nwg) return false;
        int wgid = (int)L; { const int q = nwg / NXCD, r = nwg % NXCD, xcd = wgid % NXCD, off = wgid / NXCD; wgid = (xcd < r ? xcd * (q + 1) : r * (q + 1) + (xcd - r) * q) + off; }
        const int nig = WGM * nN, gid = wgid / nig, fm = gid * WGM, gsz = (nM - fm) < WGM ? (nM - fm) : WGM;
        u.pm = fm + ((wgid % nig) % gsz); u.pn = (wgid % nig) / gsz; return true;
    }
};

template <class Epi>
__device__ __forceinline__ void gemm_phase(LAS unsigned char* lds, const Gemm g, const StaticOrder& S, const Epi& E) {
    const int tid = tid_opaque(), wid = __builtin_amdgcn_readfirstlane(tid >> 6), lane = tid & 63, wr = wid >> 2, wc = wid & 3, fr = lane & 15, fq = lane >> 4;
    const int K = g.K, nt = K / BK;
    unsigned voffA[2], voffB[2];
#pragma unroll
    for (int i = 0; i < 2; ++i) { int R, C; stage_rc(tid * 16 + i * 8192, R, C); const int Rb = Epi::PERM ? ((R & ~31) + perm32(R & 31)) : R;
        voffA[i] = (unsigned)(R * g.lda + C) * 2u; voffB[i] = (unsigned)(Rb * g.ldb + C) * 2u; }
    const size_t kstep = (size_t)(BK * 2);
    const size_t hstepA = (size_t)HALF * g.lda * 2, hstepB = (size_t)HALF * g.ldb * 2;
    const size_t tstepA = 2 * hstepA, tstepB = 2 * hstepB;
    const unsigned ldsw = (unsigned)wid * 1024u;
    const int aoff = lds_byte(wr * 64 + fr, fq * 8), boff = lds_byte(wc * 32 + fr, fq * 8);
#define PG8_SA(b, h) (((b) * 2 + (h)) * HTB)
#define PG8_SB(b, h) ((4 + (b) * 2 + (h)) * HTB)
#define PG8_STAGE(bufoff, gbase, voff) do { _Pragma("unroll") for (int _i = 0; _i < 2; ++_i) \
        __builtin_amdgcn_global_load_lds((const unsigned*)((const char*)(gbase) + (voff)[_i]), (LAS unsigned*)(lds + (bufoff) + ldsw + _i * 8192), 16, 0, 0); } while (0)
#define PG8_LDA(dst, b, h) do { _Pragma("unroll") for (int m = 0; m < 4; ++m) _Pragma("unroll") for (int k = 0; k < 2; ++k) dst[m][k] = *(const LAS bf16x8*)(lds + PG8_SA(b, h) + aoff + m * 2048 + k * 1024); } while (0)
#define PG8_LDB(dst, b, h) do { _Pragma("unroll") for (int n = 0; n < 2; ++n) _Pragma("unroll") for (int k = 0; k < 2; ++k) dst[n][k] = *(const LAS bf16x8*)(lds + PG8_SB(b, h) + boff + n * 2048 + k * 1024); } while (0)
#define PG8_MMA(ai, bj, At, Bt) do { __builtin_amdgcn_s_setprio(1); _Pragma("unroll") for (int m = 0; m < 4; ++m) _Pragma("unroll") for (int n = 0; n < 2; ++n) _Pragma("unroll") for (int k = 0; k < 2; ++k) \
        acc[ai][bj][m][n] = __builtin_amdgcn_mfma_f32_16x16x32_bf16(Bt[n][k], At[m][k], acc[ai][bj][m][n], 0, 0, 0); __builtin_amdgcn_s_setprio(0); } while (0)
#define PG8_WAIT_V(n) asm volatile("s_waitcnt vmcnt(" #n ")" ::: "memory")
#define PG8_WAIT_L(n) asm volatile("s_waitcnt lgkmcnt(" #n ")" ::: "memory")
#define PG8_BAR __builtin_amdgcn_s_barrier()
#define PG8_SCHED __builtin_amdgcn_sched_barrier(0)
    Unit cur, nxt; int ui = 0;
    if (!S.next(0, cur)) return;
    f32x4 acc[2][2][4][2];
#pragma unroll
    for (int a = 0; a < 2; ++a)
#pragma unroll
        for (int b = 0; b < 2; ++b)
#pragma unroll
            for (int m = 0; m < 4; ++m)
#pragma unroll
                for (int n = 0; n < 2; ++n) acc[a][b][m][n] = (f32x4){0.f, 0.f, 0.f, 0.f};
    bf16x8 At[4][2], B0[2][2], B1[2][2];
    const char* cA = (const char*)g.A + (size_t)cur.pm * tstepA; const char* cB = (const char*)g.Bt + (size_t)cur.pn * tstepB;
    PG8_STAGE(PG8_SB(0, 0), cB, voffB); PG8_STAGE(PG8_SB(0, 1), cB + hstepB, voffB); PG8_STAGE(PG8_SA(0, 0), cA, voffA); PG8_STAGE(PG8_SA(0, 1), cA + hstepA, voffA);
    if (wr == 1) PG8_BAR;
    PG8_WAIT_V(2); PG8_BAR;
    PG8_STAGE(PG8_SB(1, 0), cB + kstep, voffB); PG8_STAGE(PG8_SA(1, 0), cA + kstep, voffA); PG8_STAGE(PG8_SB(1, 1), cB + hstepB + kstep, voffB);
    PG8_WAIT_V(6); PG8_BAR;
    for (;;) {
        const bool has_next = S.next(ui + 1, nxt);
        const char* nA = has_next ? (const char*)g.A + (size_t)nxt.pm * tstepA : cA; const char* nB = has_next ? (const char*)g.Bt + (size_t)nxt.pn * tstepB : cB;
        for (int t = 0; t < nt; t += 2) {
            const bool last = (t == nt - 2);
            const char* a1 = cA + (size_t)(t + 1) * kstep;
            const char* a2 = last ? nA : cA + (size_t)(t + 2) * kstep; const char* b2 = last ? nB : cB + (size_t)(t + 2) * kstep;
            const char* a3 = a2 + kstep; const char* b3 = b2 + kstep;
            PG8_LDB(B0, 0, 0); PG8_LDB(B1, 0, 1); PG8_SCHED; PG8_LDA(At, 0, 0); PG8_STAGE(PG8_SA(1, 1), a1 + hstepA, voffA);
            PG8_WAIT_V(8); PG8_WAIT_L(0); PG8_BAR; PG8_MMA(0, 0, At, B0); PG8_MMA(0, 1, At, B1); PG8_BAR; PG8_SCHED;
            PG8_LDA(At, 0, 1); PG8_STAGE(PG8_SB(0, 0), b2, voffB); PG8_STAGE(PG8_SB(0, 1), b2 + hstepB, voffB); PG8_STAGE(PG8_SA(0, 0), a2, voffA);
            PG8_WAIT_V(8); PG8_WAIT_L(0); PG8_BAR; PG8_MMA(1, 0, At, B0); PG8_MMA(1, 1, At, B1); PG8_BAR; PG8_SCHED;
            PG8_LDB(B0, 1, 0); PG8_LDB(B1, 1, 1); PG8_SCHED; PG8_LDA(At, 1, 0); PG8_STAGE(PG8_SA(0, 1), a2 + hstepA, voffA);
            PG8_WAIT_V(8); PG8_WAIT_L(0); PG8_BAR; PG8_MMA(0, 0, At, B0); PG8_MMA(0, 1, At, B1); PG8_BAR; PG8_SCHED;
            PG8_LDA(At, 1, 1); PG8_STAGE(PG8_SB(1, 0), b3, voffB); PG8_STAGE(PG8_SB(1, 1), b3 + hstepB, voffB); PG8_STAGE(PG8_SA(1, 0), a3, voffA);
            PG8_WAIT_V(8); PG8_WAIT_L(0); PG8_BAR; PG8_MMA(1, 0, At, B0); PG8_MMA(1, 1, At, B1); PG8_BAR; PG8_SCHED;
        }
        if (wr == 0) PG8_BAR;
        E(acc, cur, wr, wc, fr, fq);
        PG8_WAIT_V(0);
        if (!has_next) break;
#pragma unroll
        for (int a = 0; a < 2; ++a)
#pragma unroll
            for (int b = 0; b < 2; ++b)
#pragma unroll
                for (int m = 0; m < 4; ++m)
#pragma unroll
                    for (int n = 0; n < 2; ++n) acc[a][b][m][n] = (f32x4){0.f, 0.f, 0.f, 0.f};
        cur = nxt; cA = nA; cB = nB; ++ui;
        if (wr == 1) PG8_BAR;
    }
    PG8_WAIT_V(0);
    PG8_BAR;
#undef PG8_SA
#undef PG8_SB
#undef PG8_STAGE
#undef PG8_LDA
#undef PG8_LDB
#undef PG8_MMA
#undef PG8_WAIT_V
#undef PG8_WAIT_L
#undef PG8_BAR
#undef PG8_SCHED
}
}

typedef f32x4 Acc[2][2][4][2];
DI u32x4 pack8(const float* v) { u32x4 w; w.x = pk2(v[0], v[1]); w.y = pk2(v[2], v[3]); w.z = pk2(v[4], v[5]); w.w = pk2(v[6], v[7]); return w; }
DI float quad_sum(float s) { s += __shfl_xor(s, 16); s += __shfl_xor(s, 32); return s; }

DI float rowsum32(const float* part, int row, int fq) {
    const f32x4 a = *(const f32x4*)(part + (size_t)row * 32 + 8 * fq), b = *(const f32x4*)(part + (size_t)row * 32 + 8 * fq + 4);
    return quad_sum(((a[0] + a[1]) + (a[2] + a[3])) + ((b[0] + b[1]) + (b[2] + b[3])));
}
DI float rowsum8(const float* part, int row, int fq) {
    const float a = part[(size_t)row * 8 + 2 * fq], b = part[(size_t)row * 8 + 2 * fq + 1];
    return quad_sum(a + b);
}
DI float rowsum8_full(const float* part, int row) {
    const f32x4 a = *(const f32x4*)(part + (size_t)row * 8), b = *(const f32x4*)(part + (size_t)row * 8 + 4);
    return ((a[0] + a[1]) + (a[2] + a[3])) + ((b[0] + b[1]) + (b[2] + b[3]));
}
struct EpiIn {
    static constexpr bool PERM = true;
    bf16_t* z; const float* ssq_in; float* ssq_cq; float* ssq_ckv; const float* cosr; const float* sinr; const float* cosm; const float* sinm;
    DI void operator()(const Acc& acc, const pg8::Unit& u, int wr, int wc, int fr, int fq) const {
        const int pn = u.pn;
        const int mode = pn < 3 ? 0 : pn < 6 ? 1 : pn < 12 ? 2 : pn < 14 ? 3 : pn < 16 ? 4 : pn < 20 ? 5 : 6;
#pragma unroll
        for (int ai = 0; ai < 2; ++ai)
#pragma unroll
            for (int m = 0; m < 4; ++m) {
                const int row = u.pm * 256 + ai * 128 + wr * 64 + m * 16 + fr;
                const float rs = rsqrtf(rowsum32(ssq_in, row, fq) * (1.f / DM) + EPS);
                float ss = 0.f;
#pragma unroll
                for (int bj = 0; bj < 2; ++bj) {
                    const int c0 = pn * 256 + bj * 128 + wc * 32 + 8 * fq;
                    float v[8];
#pragma unroll
                    for (int i = 0; i < 4; ++i) { v[i] = acc[ai][bj][m][0][i] * rs; v[4 + i] = acc[ai][bj][m][1][i] * rs; }
                    if (mode <= 1) {
                        const int d0 = ((c0 & 127) >> 3) * 4;
                        const f32x4 cs = *(const f32x4*)(cosr + (size_t)row * 64 + d0), sn = *(const f32x4*)(sinr + (size_t)row * 64 + d0);
                        const float sc = mode == 1 ? KSCALE_RET : 1.f;
#pragma unroll
                        for (int i = 0; i < 4; ++i) { const float x1 = v[i], x2 = v[4 + i]; v[i] = (x1 * cs[i] - x2 * sn[i]) * sc; v[4 + i] = (x2 * cs[i] + x1 * sn[i]) * sc; }
                    } else if (mode == 3 || mode == 4) {
#pragma unroll
                        for (int i = 0; i < 8; ++i) ss += v[i] * v[i];
                    } else if (mode == 5) {
#pragma unroll
                        for (int i = 0; i < 8; ++i) v[i] = gelu_tanh(v[i]);
                    } else if (mode == 6) {
                        if (c0 < Z_KPE + 64) {
                            const int d0 = ((c0 - Z_KPE) >> 3) * 4;
                            const f32x4 cs = *(const f32x4*)(cosm + (size_t)row * 32 + d0), sn = *(const f32x4*)(sinm + (size_t)row * 32 + d0);
#pragma unroll
                            for (int i = 0; i < 4; ++i) { const float x1 = v[i], x2 = v[4 + i]; v[i] = x1 * cs[i] - x2 * sn[i]; v[4 + i] = x2 * cs[i] + x1 * sn[i]; }
                        }
                    }
                    *(u32x4*)(z + (size_t)row * DINP + c0) = pack8(v);
                }
                if (mode == 3 || mode == 4) { ss = quad_sum(ss); if (fq == 0) (mode == 3 ? ssq_cq : ssq_ckv)[(size_t)row * 8 + (pn & 1) * 4 + wc] = ss; }
            }
    }
};
struct EpiQ {
    static constexpr bool PERM = true;
    bf16_t* mq; const float* ssq; const float* cosm; const float* sinm;
    DI void operator()(const Acc& acc, const pg8::Unit& u, int wr, int wc, int fr, int fq) const {
#pragma unroll
        for (int ai = 0; ai < 2; ++ai)
#pragma unroll
            for (int m = 0; m < 4; ++m) {
                const int row = u.pm * 256 + ai * 128 + wr * 64 + m * 16 + fr;
                const float rs = rsqrtf(rowsum8(ssq, row, fq) * (1.f / 512.f) + EPS) * QSCALE;
#pragma unroll
                for (int bj = 0; bj < 2; ++bj) {
                    const int c0 = u.pn * 256 + bj * 128 + wc * 32 + 8 * fq;
                    float v[8];
#pragma unroll
                    for (int i = 0; i < 4; ++i) { v[i] = acc[ai][bj][m][0][i] * rs; v[4 + i] = acc[ai][bj][m][1][i] * rs; }
                    if (c0 >= 768 && c0 < 1152) {
                        const int d0 = (((c0 - 768) & 63) >> 3) * 4;
                        const f32x4 cs = *(const f32x4*)(cosm + (size_t)row * 32 + d0), sn = *(const f32x4*)(sinm + (size_t)row * 32 + d0);
#pragma unroll
                        for (int i = 0; i < 4; ++i) { const float x1 = v[i], x2 = v[4 + i]; v[i] = x1 * cs[i] - x2 * sn[i]; v[4 + i] = x2 * cs[i] + x1 * sn[i]; }
                    }
                    *(u32x4*)(mq + (size_t)row * NQ + c0) = pack8(v);
                }
            }
    }
};
struct EpiRowScale {
    static constexpr bool PERM = true;
    bf16_t* o; int ldo; const float* ssq; float inv_n;
    DI void operator()(const Acc& acc, const pg8::Unit& u, int wr, int wc, int fr, int fq) const {
#pragma unroll
        for (int ai = 0; ai < 2; ++ai)
#pragma unroll
            for (int m = 0; m < 4; ++m) {
                const int row = u.pm * 256 + ai * 128 + wr * 64 + m * 16 + fr;
                const float rs = rsqrtf(rowsum8(ssq, row, fq) * inv_n + EPS);
#pragma unroll
                for (int bj = 0; bj < 2; ++bj) {
                    const int c0 = u.pn * 256 + bj * 128 + wc * 32 + 8 * fq;
                    float v[8];
#pragma unroll
                    for (int i = 0; i < 4; ++i) { v[i] = acc[ai][bj][m][0][i] * rs; v[4 + i] = acc[ai][bj][m][1][i] * rs; }
                    *(u32x4*)(o + (size_t)row * ldo + c0) = pack8(v);
                }
            }
    }
};
struct EpiColScale {
    static constexpr bool PERM = true;
    bf16_t* o; int ldo; const float* ssq; float inv_n;
    DI void operator()(const Acc& acc, const pg8::Unit& u, int wr, int wc, int fr, int fq) const {
#pragma unroll
        for (int bj = 0; bj < 2; ++bj) {
            const int c0 = u.pn * 256 + bj * 128 + wc * 32 + 8 * fq;
            float rs[8];
#pragma unroll
            for (int i = 0; i < 8; ++i) rs[i] = rsqrtf(rowsum8_full(ssq, c0 + i) * inv_n + EPS);
#pragma unroll
            for (int ai = 0; ai < 2; ++ai)
#pragma unroll
                for (int m = 0; m < 4; ++m) {
                    const int row = u.pm * 256 + ai * 128 + wr * 64 + m * 16 + fr;
                    float v[8];
#pragma unroll
                    for (int i = 0; i < 4; ++i) { v[i] = acc[ai][bj][m][0][i] * rs[i]; v[4 + i] = acc[ai][bj][m][1][i] * rs[4 + i]; }
                    *(u32x4*)(o + (size_t)row * ldo + c0) = pack8(v);
                }
        }
    }
};
struct EpiResid {
    static constexpr bool PERM = true;
    bf16_t* xb; float* ssq_out;
    DI void operator()(const Acc& acc, const pg8::Unit& u, int wr, int wc, int fr, int fq) const {
#pragma unroll
        for (int ai = 0; ai < 2; ++ai)
#pragma unroll
            for (int m = 0; m < 4; ++m) {
                const int row = u.pm * 256 + ai * 128 + wr * 64 + m * 16 + fr;
                float ss = 0.f;
#pragma unroll
                for (int bj = 0; bj < 2; ++bj) {
                    const size_t off = (size_t)row * DM + u.pn * 256 + bj * 128 + wc * 32 + 8 * fq;
                    const u32x4 rw = *(const u32x4*)(xb + off);
                    float o[8];
                    o[0] = bflo(rw.x) + acc[ai][bj][m][0][0]; o[1] = bfhi(rw.x) + acc[ai][bj][m][0][1]; o[2] = bflo(rw.y) + acc[ai][bj][m][0][2]; o[3] = bfhi(rw.y) + acc[ai][bj][m][0][3];
                    o[4] = bflo(rw.z) + acc[ai][bj][m][1][0]; o[5] = bfhi(rw.z) + acc[ai][bj][m][1][1]; o[6] = bflo(rw.w) + acc[ai][bj][m][1][2]; o[7] = bfhi(rw.w) + acc[ai][bj][m][1][3];
                    *(u32x4*)(xb + off) = pack8(o);
#pragma unroll
                    for (int i = 0; i < 8; ++i) ss += o[i] * o[i];
                }
                ss = quad_sum(ss);
                if (fq == 0) ssq_out[(size_t)row * 32 + u.pn * 4 + wc] = ss;
            }
    }
};
struct EpiGLU {
    static constexpr bool PERM = true;
    bf16_t* hid; const float* ssq;
    DI void operator()(const Acc& acc, const pg8::Unit& u, int wr, int wc, int fr, int fq) const {
#pragma unroll
        for (int ai = 0; ai < 2; ++ai)
#pragma unroll
            for (int m = 0; m < 4; ++m) {
                const int row = u.pm * 256 + ai * 128 + wr * 64 + m * 16 + fr;
                const float rs = rsqrtf(rowsum32(ssq, row, fq) * (1.f / DM) + EPS);
                float v[8];
#pragma unroll
                for (int i = 0; i < 4; ++i) {
                    v[i] = silu(acc[ai][0][m][0][i] * rs) * (acc[ai][1][m][0][i] * rs);
                    v[4 + i] = silu(acc[ai][0][m][1][i] * rs) * (acc[ai][1][m][1][i] * rs);
                }
                *(u32x4*)(hid + (size_t)row * DFF + u.pn * 128 + wc * 32 + 8 * fq) = pack8(v);
            }
    }
};

struct ColMapIn { const float* w; DI const float* operator()(int n) const {
    if (n < 1536) { const int p = n & 127, a = p >> 3, i = p & 7; return w + (n - p) + 4 * a + (i & 3) + 64 * (i >> 2); }
    if (n < 4096) return w + n;
    if (n < 5120) return w + n + 64;
    if (n < 5184) { const int p = n - 5120, a = p >> 3, i = p & 7; return w + 4096 + 4 * a + (i & 3) + 32 * (i >> 2); }
    return nullptr; } };
struct ColMapUq { const float* w; DI const float* operator()(int n) const {
    if (n < 768) return w + (n >> 7) * 192 + (n & 127);
    if (n < 1152) { const int q = n - 768, hh = q >> 6, p = q & 63, a = p >> 3, i = p & 7; return w + hh * 192 + 128 + 4 * a + (i & 3) + 32 * (i >> 2); }
    return nullptr; } };
struct ColMapKv { const float* w; int off; DI const float* operator()(int n) const { return w + (n >> 7) * 256 + off + (n & 127); } };
struct ColMapId { const float* w; DI const float* operator()(int n) const { return w + n; } };
struct ColMapGu { const float* wg; const float* wu; DI const float* operator()(int n) const { const int t = n >> 8, r = n & 255; return r < 128 ? wg + t * 128 + r : wu + t * 128 + (r - 128); } };

template <class CM>
DI void convert_T(LAS float* tile, bf16_t* dst, int K, int Nd, int srcN, const float* gain, const CM cm, int bid, int nb, int& off) {
    const int tid = tid_opaque(), n4 = tid & 31, kk = tid >> 5;
    const int nkt = K / 64, nnt = Nd / 128, nitems = nkt * nnt;
    int it = bid - off; if (it < 0) it += nb;
    off = (off + nitems) % nb;
    constexpr int NF = 4;
    f32x4 v[NF][4];
#define CVT_LOAD(f, item_) do { const int k0_ = ((item_) / nnt) * 64, n0_ = ((item_) % nnt) * 128; const float* src_ = cm(n0_ + 4 * n4); \
        _Pragma("unroll") for (int p = 0; p < 4; ++p) { const int k_ = k0_ + kk + 16 * p; \
            if (src_) { v[f][p] = *(const f32x4*)(src_ + (size_t)k_ * srcN); if (gain) { const float g_ = gain[k_]; v[f][p] = v[f][p] * g_; } } else v[f][p] = (f32x4){0.f, 0.f, 0.f, 0.f}; } } while (0)
#define CVT_STORE(f, item_) do { const int k0_ = ((item_) / nnt) * 64, n0_ = ((item_) % nnt) * 128; \
        _Pragma("unroll") for (int p = 0; p < 4; ++p) { const int k_ = kk + 16 * p; *(LAS f32x4*)(tile + k_ * 128 + ((4 * n4) ^ (8 * ((k_ >> 3) & 3)))) = v[f][p]; } \
        __syncthreads(); \
        if ((item_) + NF * nb < nitems) CVT_LOAD(f, (item_) + NF * nb); \
        _Pragma("unroll") for (int q = 0; q < 2; ++q) { const int c = tid & 7, n = (tid >> 3) + 64 * q, nsw = n ^ (8 * (c & 3)); float o[8];     \
            _Pragma("unroll") for (int j = 0; j < 8; ++j) o[j] = tile[(8 * c + j) * 128 + nsw]; \
            *(u32x4*)(dst + (size_t)(n0_ + n) * K + k0_ + 8 * c) = pack8(o); } \
        __syncthreads(); } while (0)
#pragma unroll
    for (int f = 0; f < NF; ++f) if (it + f * nb < nitems) CVT_LOAD(f, it + f * nb);
    for (; it < nitems; it += NF * nb) {
#pragma unroll
        for (int f = 0; f < NF; ++f) if (it + f * nb < nitems) CVT_STORE(f, it + f * nb);
    }
#undef CVT_LOAD
#undef CVT_STORE
}

constexpr int T136 = 136, TILE_B = 128 * T136 * 2;
DI void mm128(const LAS unsigned char* A, const LAS unsigned char* Bt, f32x4 (&acc)[8], int w, int fr, int fq) {
#pragma unroll
    for (int ks = 0; ks < 4; ++ks) {
        const bf16x8 a = *(const LAS bf16x8*)(A + ((16 * w + fr) * T136 + 32 * ks + 8 * fq) * 2);
#pragma unroll
        for (int nb = 0; nb < 8; ++nb) {
            const bf16x8 b = *(const LAS bf16x8*)(Bt + ((16 * nb + fr) * T136 + 32 * ks + 8 * fq) * 2);
            acc[nb] = __builtin_amdgcn_mfma_f32_16x16x32_bf16(b, a, acc[nb], 0, 0, 0);
        }
    }
}
DI void stage_rows(int tid, LAS unsigned char* T, const bf16_t* g, size_t ld) {
#pragma unroll
    for (int p = 0; p < 4; ++p) { const int q = tid + 512 * p, r = q >> 4, c = q & 15; *(LAS u32x4*)(T + (r * T136 + 8 * c) * 2) = *(const u32x4*)(g + (size_t)r * ld + 8 * c); }
}
DI void tile_load(int tid, u32x4 (&v)[4], const bf16_t* g, size_t ld) {
    const int r = tid & 127;
#pragma unroll
    for (int p = 0; p < 4; ++p) v[p] = *(const u32x4*)(g + (size_t)r * ld + 8 * ((tid >> 7) + 4 * p));
}
DI void tile_store_T(int tid, LAS unsigned char* T, const u32x4 (&v)[4], const LAS float* rowscale, const float* colgain) {
    const int r = tid & 127;
    const float rs = rowscale ? rowscale[r] : 1.f;
#pragma unroll
    for (int p = 0; p < 4; ++p) {
        const int cc = (tid >> 7) + 4 * p;
        const unsigned w[4] = {v[p].x, v[p].y, v[p].z, v[p].w};
#pragma unroll
        for (int j = 0; j < 4; ++j) {
            const int c0 = 8 * cc + 2 * j;
            float a = bflo(w[j]) * rs, b = bfhi(w[j]) * rs;
            if (colgain) { a *= colgain[c0]; b *= colgain[c0 + 1]; }
            *(LAS unsigned short*)(T + ((c0) * T136 + r) * 2) = (unsigned short)f2bf(a);
            *(LAS unsigned short*)(T + ((c0 + 1) * T136 + r) * 2) = (unsigned short)f2bf(b);
        }
    }
}

DI float ret_log_gamma(int h) {
    return h == 0 ? -3.1748698315e-02f : h == 1 ? -1.5748356968e-02f : h == 2 ? -7.8431774610e-03f : h == 3 ? -3.9138993211e-03f : h == 4 ? -1.9550348358e-03f : -9.7703964783e-04f; }

DI void ret_kv_unit(LAS unsigned char* lds, int n, int h, const bf16_t* z, float* kvT) {
    const int tid = tid_opaque(), w = tid >> 6, lane = tid & 63, fr = lane & 15, fq = lane >> 4;
    LAS unsigned char* TA = lds; LAS unsigned char* TB = lds + TILE_B; LAS float* dec = (LAS float*)(lds + 2 * TILE_B);
    const float lg = ret_log_gamma(h);
    const bf16_t* zr = z + (size_t)n * 128 * DINP;
    u32x4 vv[4], kk[4];
    tile_load(tid, vv, zr + Z_RV + h * 128, DINP); tile_load(tid, kk, zr + Z_RK + h * 128, DINP);
    __syncthreads();
    if (tid < 128) dec[tid] = __expf(lg * (127.f - (float)tid));
    __syncthreads();
    tile_store_T(tid, TA, vv, nullptr, nullptr);
    tile_store_T(tid, TB, kk, dec, nullptr);
    __syncthreads();
    f32x4 acc[8];
#pragma unroll
    for (int i = 0; i < 8; ++i) acc[i] = (f32x4){0.f, 0.f, 0.f, 0.f};
    mm128(TA, TB, acc, w, fr, fq);
    float* o = kvT + ((size_t)(n * 6 + h) * 128 + 16 * w + fr) * 128 + 4 * fq;
#pragma unroll
    for (int nb = 0; nb < 8; ++nb) *(f32x4*)(o + 16 * nb) = acc[nb];
}

DI void ret_out_unit(LAS unsigned char* lds, int n, int h, const bf16_t* z, const bf16_t* prevT, const float* mixg, bf16_t* y) {
    const int tid = tid_opaque(), w = tid >> 6, lane = tid & 63, fr = lane & 15, fq = lane >> 4;
    LAS unsigned char* TQ = lds; LAS unsigned char* TK = lds + TILE_B; LAS unsigned char* TS = lds + 2 * TILE_B; LAS unsigned char* TP = lds + 3 * TILE_B;
    const float lg = ret_log_gamma(h);
    const bf16_t* zr = z + (size_t)n * 128 * DINP;
    u32x4 vv[4];
    tile_load(tid, vv, zr + Z_RV + h * 128, DINP);
    __syncthreads();
    stage_rows(tid, TQ, zr + Z_RQ + h * 128, DINP);
    stage_rows(tid, TK, zr + Z_RK + h * 128, DINP);
    stage_rows(tid, TP, prevT + (size_t)(n * 6 + h) * 16384, 128);
    __syncthreads();
    f32x4 acc[8];
#pragma unroll
    for (int i = 0; i < 8; ++i) acc[i] = (f32x4){0.f, 0.f, 0.f, 0.f};
    mm128(TQ, TK, acc, w, fr, fq);
    const int irow = 16 * w + fr;
#pragma unroll
    for (int nb = 0; nb < 8; ++nb) {
        float v[4];
#pragma unroll
        for (int i = 0; i < 4; ++i) { const int j = 16 * nb + 4 * fq + i; const int rel = irow - j; v[i] = rel >= 0 ? acc[nb][i] * __expf(lg * (float)rel) : 0.f; }
        u32x2 wv; wv.x = pk2(v[0], v[1]); wv.y = pk2(v[2], v[3]);
        *(LAS u32x2*)(TS + (irow * T136 + 16 * nb + 4 * fq) * 2) = wv;
    }
    __syncthreads();
    tile_store_T(tid, TK, vv, nullptr, nullptr);
    __syncthreads();
    f32x4 a1[8], a2[8];
#pragma unroll
    for (int i = 0; i < 8; ++i) { a1[i] = (f32x4){0.f, 0.f, 0.f, 0.f}; a2[i] = (f32x4){0.f, 0.f, 0.f, 0.f}; }
    mm128(TS, TK, a1, w, fr, fq);
    mm128(TQ, TP, a2, w, fr, fq);
    const float qd = __expf(lg * (float)(irow + 1));
    float ss = 0.f;
#pragma unroll
    for (int nb = 0; nb < 8; ++nb)
#pragma unroll
        for (int i = 0; i < 4; ++i) { const float o = a1[nb][i] + qd * a2[nb][i]; a1[nb][i] = o; ss += o * o; }
    ss = quad_sum(ss);
    const float rs = rsqrtf(ss * (1.f / 128.f) + EPS);
    const size_t tok = (size_t)n * 128 + irow;
#pragma unroll
    for (int nb = 0; nb < 8; ++nb) {
        const int e0 = 16 * nb + 4 * fq;
        const u32x2 gw = *(const u32x2*)(z + tok * DINP + Z_RG + h * 128 + e0);
        const f32x4 mg = *(const f32x4*)(mixg + h * 128 + e0);
        const float g0 = silu(bflo(gw.x)), g1 = silu(bfhi(gw.x)), g2 = silu(bflo(gw.y)), g3 = silu(bfhi(gw.y));
        u32x2 o; o.x = pk2(a1[nb][0] * rs * mg[0] * g0, a1[nb][1] * rs * mg[1] * g1); o.y = pk2(a1[nb][2] * rs * mg[2] * g2, a1[nb][3] * rs * mg[3] * g3);
        *(u32x2*)(y + tok * DM + h * 128 + e0) = o;
    }
}

DI void gmlp_unit(LAS unsigned char* lds, int n, int g, const bf16_t* z, const float* w_s, const float* b_s, const float* vgain, const float* mixg, bf16_t* y) {
    const int tid = tid_opaque(), w = tid >> 6, lane = tid & 63, fr = lane & 15, fq = lane >> 4;
    LAS unsigned char* TA = lds; LAS unsigned char* TB = lds + TILE_B; LAS float* part = (LAS float*)(lds + 2 * TILE_B); LAS float* rstd = part + 512;
    const bf16_t* zr = z + (size_t)n * 128 * DINP;
    __syncthreads();
    u32x4 vv[4];
    tile_load(tid, vv, zr + Z_GV + g * 128, DINP);
    {
        const int r = tid & 127; float ss = 0.f;
#pragma unroll
        for (int p = 0; p < 4; ++p) { const unsigned wv[4] = {vv[p].x, vv[p].y, vv[p].z, vv[p].w};
#pragma unroll
            for (int j = 0; j < 4; ++j) { const float a = bflo(wv[j]), b = bfhi(wv[j]); ss += a * a + b * b; } }
        part[(tid >> 7) * 128 + r] = ss;
    }
    __syncthreads();
    if (tid < 128) rstd[tid] = rsqrtf((part[tid] + part[128 + tid] + part[256 + tid] + part[384 + tid]) * (1.f / 128.f) + EPS);
    {
        const float* ws = w_s + (size_t)g * 16384;
#pragma unroll
        for (int p = 0; p < 8; ++p) { const int q = tid + 512 * p, t = q >> 5, s0 = (q & 31) * 4; const f32x4 v = *(const f32x4*)(ws + t * 128 + s0);
            u32x2 o; o.x = pk2(s0 <= t ? v[0] : 0.f, s0 + 1 <= t ? v[1] : 0.f); o.y = pk2(s0 + 2 <= t ? v[2] : 0.f, s0 + 3 <= t ? v[3] : 0.f);
            *(LAS u32x2*)(TA + (t * T136 + s0) * 2) = o; }
    }
    __syncthreads();
    tile_store_T(tid, TB, vv, rstd, vgain + g * 128);
    __syncthreads();
    f32x4 acc[8];
#pragma unroll
    for (int i = 0; i < 8; ++i) acc[i] = (f32x4){0.f, 0.f, 0.f, 0.f};
    mm128(TA, TB, acc, w, fr, fq);
    const int t = 16 * w + fr; const size_t tok = (size_t)n * 128 + t;
    const float bias = b_s[g * 128 + t];
    float ss = 0.f;
#pragma unroll
    for (int nb = 0; nb < 8; ++nb) {
        const u32x2 uw = *(const u32x2*)(z + tok * DINP + Z_GU + g * 128 + 16 * nb + 4 * fq);
        const float u0 = bflo(uw.x), u1 = bfhi(uw.x), u2 = bflo(uw.y), u3 = bfhi(uw.y);
        acc[nb][0] = u0 * (acc[nb][0] + bias); acc[nb][1] = u1 * (acc[nb][1] + bias); acc[nb][2] = u2 * (acc[nb][2] + bias); acc[nb][3] = u3 * (acc[nb][3] + bias);
        ss += (acc[nb][0] * acc[nb][0] + acc[nb][1] * acc[nb][1]) + (acc[nb][2] * acc[nb][2] + acc[nb][3] * acc[nb][3]);
    }
    ss = quad_sum(ss);
    const float rs = rsqrtf(ss * (1.f / 128.f) + EPS);
#pragma unroll
    for (int nb = 0; nb < 8; ++nb) {
        const int c0 = 1536 + g * 128 + 16 * nb + 4 * fq;
        const f32x4 mg = *(const f32x4*)(mixg + c0);
        u32x2 o; o.x = pk2(acc[nb][0] * rs * mg[0], acc[nb][1] * rs * mg[1]); o.y = pk2(acc[nb][2] * rs * mg[2], acc[nb][3] * rs * mg[3]);
        *(u32x2*)(y + tok * DM + c0) = o;
    }
}

constexpr int KSTR = 400, VSTR = 136, ABUF = 45056, AV_OFF = 25600;
__device__ const unsigned ATT_UNITS[80] = {0x8a4001fu, 0x8c8041fu, 0x8ec081fu, 0x9100c1fu, 0x4c40017u, 0x4e80417u, 0x50c0817u, 0x1e4000fu, 0x208040fu, 0x40007u, 0x823e01eu, 0x847c3feu, 0x86ba7deu, 0x88f8bbeu, 0x463e016u, 0x487c3f6u, 0x7a3c01du, 0x7c783ddu, 0x7eb479du, 0x80f0b5du, 0x4ab87d6u, 0x403c015u, 0x1a3c00eu, 0x1c783ceu, 0x723a01cu, 0x74743bcu, 0x76ae75cu, 0x78e8afcu, 0x42763d5u, 0x44b0775u, 0x6a3801bu, 0x6c7039bu, 0x6ea871bu, 0x70e0a9bu, 0x3a38014u, 0x3c70394u, 0x3ea8714u, 0x163800du, 0x187038du, 0x38006u, 0x623601au, 0x646c37au, 0x66a26dau, 0x68d8a3au, 0x3436013u, 0x366c373u, 0x5a34019u, 0x5c68359u, 0x5e9c699u, 0x60d09d9u, 0x38a06d3u, 0x2e34012u, 0x123400cu, 0x146834cu, 0x5232018u, 0x5464338u, 0x5696658u, 0x58c8978u, 0x3066352u, 0x3298672u, 0x2830011u, 0x2a60311u, 0x2c90611u, 0xe3000bu, 0x106030bu, 0x30005u, 0x222e010u, 0x245c2f0u, 0x26885d0u, 0xa2c00au, 0xc582cau, 0x628009u, 0x850289u, 0x28004u, 0x224008u, 0x448248u, 0x20003u, 0x18002u, 0x10001u, 0x8000u};
DI void attn_finish(f32x16 (&o)[4], float l, int h, int qrow, int hi, const float* mixg, bf16_t* y) {
    const float inv = __builtin_amdgcn_rcpf(l);
    float ss = 0.f;
#pragma unroll
    for (int i = 0; i < 4; ++i)
#pragma unroll
        for (int r = 0; r < 16; ++r) { const float v = o[i][r] * inv; o[i][r] = v; ss += v * v; }
    ss = half_sum(ss);
    const float rs = rsqrtf(ss * (1.f / 128.f) + EPS);
    bf16_t* yr = y + (size_t)qrow * DM + 768 + 128 * h;
    const float* mg = mixg + 768 + 128 * h;
#pragma unroll
    for (int db = 0; db < 4; ++db)
#pragma unroll
        for (int gq = 0; gq < 4; ++gq) {
            const int d0 = 32 * db + 8 * gq + 4 * hi;
            const f32x4 gg = *(const f32x4*)(mg + d0);
            u32x2 ov; ov.x = pk2(o[db][4 * gq] * rs * gg[0], o[db][4 * gq + 1] * rs * gg[1]); ov.y = pk2(o[db][4 * gq + 2] * rs * gg[2], o[db][4 * gq + 3] * rs * gg[3]);
            *(u32x2*)(yr + d0) = ov;
        }
}
DI void attn_combine_wave(const float* rec, int k, int h, int qrow0, int lane, const float* mixg, bf16_t* y) {
    const int r32 = lane & 31, hi = lane >> 5;
    float mt = -1e30f;
    for (int i = 0; i < k; ++i) mt = fmaxf(mt, rec[(size_t)i * APART_REC + 32 * 64 + lane]);
    f32x16 o[4];
#pragma unroll
    for (int i = 0; i < 4; ++i)
#pragma unroll
        for (int r = 0; r < 16; ++r) o[i][r] = 0.f;
    float lt = 0.f;
#pragma unroll 1
    for (int i = 0; i < k; ++i) {
        const float* ri = rec + (size_t)i * APART_REC; const unsigned* rw = (const unsigned*)ri;
        const float a = __builtin_amdgcn_exp2f(ri[32 * 64 + lane] - mt);
        lt += ri[33 * 64 + lane] * a;
        unsigned wv[32];
#pragma unroll
        for (int q = 0; q < 32; ++q) wv[q] = rw[q * 64 + lane];
#pragma unroll
        for (int d = 0; d < 4; ++d)
#pragma unroll
            for (int r = 0; r < 16; r += 2) { const unsigned w = wv[d * 8 + (r >> 1)]; o[d][r] += bflo(w) * a; o[d][r + 1] += bfhi(w) * a; }
    }
    attn_finish(o, lt, h, qrow0 + r32, hi, mixg, y);
}
DI void attn_unit(LAS unsigned char* lds, int h, int qb, int s_begin, int s_end, float* part, const bf16_t* mq, const bf16_t* kn, const bf16_t* z, const bf16_t* vt, const float* mixg, bf16_t* y) {
    const int tid = tid_opaque(), w = tid >> 6, lane = tid & 63, r32 = lane & 31, hi = lane >> 5;
    const int q0 = 256 * qb + 32 * w;
    bf16x8 qf[12];
    {
        const bf16_t* qr = mq + (size_t)(q0 + r32) * NQ;
#pragma unroll
        for (int ks = 0; ks < 8; ++ks) qf[ks] = *(const bf16x8*)(qr + 128 * h + 16 * ks + 8 * hi);
#pragma unroll
        for (int ks = 0; ks < 4; ++ks) qf[8 + ks] = *(const bf16x8*)(qr + 768 + 64 * h + 16 * ks + 8 * hi);
    }
    f32x16 o[4];
#pragma unroll
    for (int i = 0; i < 4; ++i)
#pragma unroll
        for (int r = 0; r < 16; ++r) o[i][r] = 0.f;
    float mrow = -1e30f, lrow = 0.f;
    u32x4 kreg[3], vreg[2];
    const bf16_t* knsrc = kn + (size_t)(tid >> 4) * NKV + 128 * h + 8 * (tid & 15);
    const bf16_t* kpsrc = z + (size_t)(tid >> 3) * DINP + Z_KPE + 8 * (tid & 7);
    const bf16_t* vsrc = vt + (size_t)(128 * h + (tid >> 3)) * S + 8 * (tid & 7);
    const int kndst = (tid >> 4) * KSTR + (tid & 15) * 16, kpdst = (tid >> 3) * KSTR + 256 + (tid & 7) * 16;
    const int vdst = AV_OFF + (tid >> 3) * VSTR + (tid & 7) * 16;
#define ATT_LOAD(step_) do { const size_t k0_ = (size_t)64 * (step_); \
        kreg[0] = *(const u32x4*)(knsrc + k0_ * NKV); kreg[1] = *(const u32x4*)(knsrc + (k0_ + 32) * NKV); kreg[2] = *(const u32x4*)(kpsrc + k0_ * DINP); \
        vreg[0] = *(const u32x4*)(vsrc + k0_); vreg[1] = *(const u32x4*)(vsrc + (size_t)64 * S + k0_); } while (0)
#define ATT_STORE(buf_) do { LAS unsigned char* b_ = lds + (buf_) * ABUF; \
        *(LAS u32x4*)(b_ + kndst) = kreg[0]; *(LAS u32x4*)(b_ + kndst + 32 * KSTR) = kreg[1]; *(LAS u32x4*)(b_ + kpdst) = kreg[2]; \
        *(LAS u32x2*)(b_ + vdst) = (u32x2){vreg[0].x, vreg[0].y}; *(LAS u32x2*)(b_ + vdst + 8) = (u32x2){vreg[0].z, vreg[0].w}; \
        *(LAS u32x2*)(b_ + vdst + 64 * VSTR) = (u32x2){vreg[1].x, vreg[1].y}; *(LAS u32x2*)(b_ + vdst + 64 * VSTR + 8) = (u32x2){vreg[1].z, vreg[1].w}; } while (0)
    ATT_LOAD(s_begin);
    ATT_STORE(0);
    if (s_begin + 1 < s_end) ATT_LOAD(s_begin + 1);
    __syncthreads();
    for (int step = s_begin; step < s_end; ++step) {
        const int cur = (step - s_begin) & 1;
        if (step + 1 < s_end) { ATT_STORE(cur ^ 1); if (step + 2 < s_end) ATT_LOAD(step + 2); }
        const int jd = step - 4 * qb;
        if (!(jd >= 0 && 64 * jd > 32 * w + 31)) {
            const LAS unsigned char* kt = lds + cur * ABUF;
            f32x16 p0, p1;
#pragma unroll
            for (int r = 0; r < 16; ++r) { p0[r] = 0.f; p1[r] = 0.f; }
            const LAS unsigned char* kb0 = kt + r32 * KSTR + 16 * hi;
            const LAS unsigned char* vb0 = kt + AV_OFF + r32 * VSTR + 8 * hi;
#define ATT_SCHED __builtin_amdgcn_sched_barrier(0)
#define KLOAD(dst, b_) do { _Pragma("unroll") for (int j = 0; j < 2; ++j) { dst[j][0] = *(const LAS bf16x8*)(kb0 + 32 * (2 * (b_) + j)); dst[j][1] = *(const LAS bf16x8*)(kb0 + 32 * KSTR + 32 * (2 * (b_) + j)); } } while (0)
#define KMMA(src, b_) do { _Pragma("unroll") for (int j = 0; j < 2; ++j) { p0 = __builtin_amdgcn_mfma_f32_32x32x16_bf16(src[j][0], qf[2 * (b_) + j], p0, 0, 0, 0); p1 = __builtin_amdgcn_mfma_f32_32x32x16_bf16(src[j][1], qf[2 * (b_) + j], p1, 0, 0, 0); } } while (0)
#define VLOAD(dst, db_) do { _Pragma("unroll") for (int kb = 0; kb < 2; ++kb) _Pragma("unroll") for (int s = 0; s < 2; ++s) { const LAS unsigned char* vp = vb0 + (db_) * 32 * VSTR + (32 * kb + 16 * s) * 2; \
                const s16x4 lo = *(const LAS s16x4*)vp, hi4 = *(const LAS s16x4*)(vp + 16); dst[2 * kb + s] = __builtin_shufflevector(lo, hi4, 0, 1, 2, 3, 4, 5, 6, 7); } } while (0)
#define VMMA(src, db_) do { _Pragma("unroll") for (int i = 0; i < 4; ++i) o[db_] = __builtin_amdgcn_mfma_f32_32x32x16_bf16(src[i], pf[i], o[db_], 0, 0, 0); } while (0)
            {
                bf16x8 kA[2][2], kB[2][2];
                KLOAD(kA, 0); ATT_SCHED;
                KLOAD(kB, 1); ATT_SCHED; KMMA(kA, 0); ATT_SCHED;
                KLOAD(kA, 2); ATT_SCHED; KMMA(kB, 1); ATT_SCHED;
                KLOAD(kB, 3); ATT_SCHED; KMMA(kA, 2); ATT_SCHED;
                KLOAD(kA, 4); ATT_SCHED; KMMA(kB, 3); ATT_SCHED;
                KLOAD(kB, 5); ATT_SCHED; KMMA(kA, 4); ATT_SCHED;
                KMMA(kB, 5); ATT_SCHED;
            }
            bf16x8 vA[4], vB[4];
            VLOAD(vA, 0); ATT_SCHED;
            if (jd >= 0) {
                const int qrel = 32 * w + r32;
#pragma unroll
                for (int r = 0; r < 16; ++r) { const int kr = 64 * jd + (r & 3) + 8 * (r >> 2) + 4 * hi; if (kr > qrel) p0[r] = -INFINITY; if (kr + 32 > qrel) p1[r] = -INFINITY; }
            }
            float mx = fmaxf(p0[0], p1[0]);
#pragma unroll
            for (int r = 1; r < 16; ++r) mx = fmaxf(mx, fmaxf(p0[r], p1[r]));
            mx = half_max(mx);
            if (__any(mx > mrow + 8.f)) {
                const float mnew = fmaxf(mrow, mx);
                const float alpha = __builtin_amdgcn_exp2f(mrow - mnew);
                lrow *= alpha; mrow = mnew;
#pragma unroll
                for (int i = 0; i < 4; ++i)
#pragma unroll
                    for (int r = 0; r < 16; ++r) o[i][r] *= alpha;
            }
            float ls = 0.f;
#pragma unroll
            for (int r = 0; r < 16; ++r) { p0[r] = __builtin_amdgcn_exp2f(p0[r] - mrow); p1[r] = __builtin_amdgcn_exp2f(p1[r] - mrow); ls += p0[r] + p1[r]; }
            lrow += ls;
            bf16x8 pf[4];
#pragma unroll
            for (int s = 0; s < 2; ++s) {
                u32x4 a, b;
                a.x = pk2(p0[8 * s + 0], p0[8 * s + 1]); a.y = pk2(p0[8 * s + 2], p0[8 * s + 3]); a.z = pk2(p0[8 * s + 4], p0[8 * s + 5]); a.w = pk2(p0[8 * s + 6], p0[8 * s + 7]);
                b.x = pk2(p1[8 * s + 0], p1[8 * s + 1]); b.y = pk2(p1[8 * s + 2], p1[8 * s + 3]); b.z = pk2(p1[8 * s + 4], p1[8 * s + 5]); b.w = pk2(p1[8 * s + 6], p1[8 * s + 7]);
                pf[s] = __builtin_bit_cast(bf16x8, a); pf[2 + s] = __builtin_bit_cast(bf16x8, b);
            }
            ATT_SCHED;
            VLOAD(vB, 1); ATT_SCHED; VMMA(vA, 0); ATT_SCHED;
            VLOAD(vA, 2); ATT_SCHED; VMMA(vB, 1); ATT_SCHED;
            VLOAD(vB, 3); ATT_SCHED; VMMA(vA, 2); ATT_SCHED;
            VMMA(vB, 3); ATT_SCHED;
#undef KLOAD
#undef KMMA
#undef VLOAD
#undef VMMA
#undef ATT_SCHED
        }
        __syncthreads();
    }
#undef ATT_LOAD
#undef ATT_STORE
    lrow = half_sum(lrow);
    if (part) {
        float* rec = part + (size_t)w * 34 * 64; unsigned* rw = (unsigned*)rec;
#pragma unroll
        for (int i = 0; i < 4; ++i)
#pragma unroll
            for (int r = 0; r < 16; r += 2) rw[(i * 8 + (r >> 1)) * 64 + lane] = pk2(o[i][r], o[i][r + 1]);
        rec[32 * 64 + lane] = mrow; rec[33 * 64 + lane] = lrow;
    } else attn_finish(o, lrow, h, q0 + r32, hi, mixg, y);
}

#define XB_TMO      128
#define XB_XCNT(j)  (256  + 64 * (j))
#define XB_XSUB(j)  (1280 + 64 * (j))
#define XB_XGEN(j)  (2304 + 64 * (j))
#define XB_TOP      3328
#define XB_TOPGEN   3392
#define XCD_BAR_WORDS 3456
#define XB_SPIN_CAP (1u << 20)
DI unsigned xb_ld(unsigned* p)              { return __hip_atomic_load(p, __ATOMIC_RELAXED, __HIP_MEMORY_SCOPE_AGENT); }
DI unsigned xb_add(unsigned* p, unsigned v) { return __hip_atomic_fetch_add(p, v, __ATOMIC_RELAXED, __HIP_MEMORY_SCOPE_AGENT); }
DI unsigned xb_xcc_id() { return (unsigned)__builtin_amdgcn_s_getreg((3 << 11) | 20) & 0xFu; }
#define XB_SPIN(cond, bar) do { unsigned _sp = 0; while (cond) { __builtin_amdgcn_s_sleep(1); \
    if ((++_sp & 255u) == 0u) { if (xb_ld(&(bar)[XB_TMO])) break; if (_sp > XB_SPIN_CAP) { atomicAdd(&(bar)[XB_TMO], 1u); break; } } } } while (0)
struct XcdBarrier { unsigned* bar; unsigned x; volatile LAS unsigned* st; };
DI XcdBarrier xcd_barrier_post(unsigned* bar, volatile LAS unsigned* st) {
    XcdBarrier b; b.bar = bar; b.x = xb_xcc_id(); b.st = st;
    if (threadIdx.x == 0) (void)xb_add(&bar[XB_XCNT(b.x)], 1u);
    return b;
}
DI void xcd_barrier_complete(unsigned* bar, unsigned x, unsigned& nloc, unsigned& nx) {
    const unsigned G = gridDim.x * gridDim.y * gridDim.z;
    unsigned sum, cnt, mine, sp = 0u;
    for (;;) {
        sum = 0u; cnt = 0u; mine = 0u;
#pragma unroll
        for (unsigned j = 0; j < 16; ++j) { const unsigned c = xb_ld(&bar[XB_XCNT(j)]); sum += c; cnt += (c > 0u) ? 1u : 0u; mine = (j == x) ? c : mine; }
        if (sum == G) break;
        __builtin_amdgcn_s_sleep(1);
        if ((++sp & 255u) == 0u) { if (xb_ld(&bar[XB_TMO])) break; if (sp > XB_SPIN_CAP) { atomicAdd(&bar[XB_TMO], 1u); break; } }
    }
    nloc = mine > 0u ? mine : 1u; nx = cnt > 0u ? cnt : 1u;
}
DI void xcd_barrier(const XcdBarrier& b) {
    asm volatile("s_waitcnt vmcnt(0)" ::: "memory");
    __syncthreads();
    if (threadIdx.x == 0) {
        unsigned* bar = b.bar;
        __builtin_amdgcn_s_waitcnt(0);
        unsigned nloc = b.st[0], nx = b.st[1];
        if (nloc == 0u) { xcd_barrier_complete(bar, b.x, nloc, nx); b.st[0] = nloc; b.st[1] = nx; }
        const unsigned old = xb_add(&bar[XB_XSUB(b.x)], 1u);
        const unsigned gen = old / nloc;
        if (old + 1u == (gen + 1u) * nloc) {
            __builtin_amdgcn_fence(__ATOMIC_RELEASE, "agent");
            asm volatile("s_waitcnt vmcnt(0)" ::: "memory");
            const unsigned og = xb_add(&bar[XB_TOP], 1u);
            const unsigned tg = og / nx;
            if (og + 1u == (tg + 1u) * nx) xb_add(&bar[XB_TOPGEN], 1u);
            else XB_SPIN(xb_ld(&bar[XB_TOPGEN]) == tg, bar);
            __builtin_amdgcn_fence(__ATOMIC_ACQUIRE, "agent");
            xb_add(&bar[XB_XGEN(b.x)], 1u);
            asm volatile("s_waitcnt vmcnt(0)" ::: "memory");
        } else {
            XB_SPIN(xb_ld(&bar[XB_XGEN(b.x)]) == gen, bar);
            __builtin_amdgcn_fence(__ATOMIC_ACQUIRE, "agent");
            asm volatile("s_waitcnt vmcnt(0)" ::: "memory");
        }
    }
    __syncthreads();
}

typedef const Params __attribute__((address_space(4))) CParams;
DI CParams* params_opaque() { unsigned long long p = (unsigned long long)__builtin_amdgcn_kernarg_segment_ptr(); asm volatile("" : "+s"(p)); return (CParams*)p; }
#define WSPTR(T, off) ((T*)(ws + (off)))

DI void phase_prologue(LAS unsigned char* lds) {
    CParams* P = params_opaque();
    const int tid = tid_opaque(), bid = blockIdx.x, G = gridDim.x, wave = tid >> 6, lane = tid & 63;
    unsigned char* ws = P->ws;
    float* pattn = WSPTR(float, WS_PATTN);
    {
        const float* x = P->x; bf16_t* xb = WSPTR(bf16_t, WS_XB);
        for (int row = bid * 8 + wave; row < S; row += G * 8) {
            const float* xr = x + (size_t)row * DM; float ss = 0.f;
#pragma unroll
            for (int j = 0; j < 8; ++j) { const f32x4 v = *(const f32x4*)(xr + 4 * lane + 256 * j); ss += (v[0] * v[0] + v[1] * v[1]) + (v[2] * v[2] + v[3] * v[3]);
                u32x2 o; o.x = pk2(v[0], v[1]); o.y = pk2(v[2], v[3]); *(u32x2*)(xb + (size_t)row * DM + 4 * lane + 256 * j) = o; }
#pragma unroll
            for (int o = 1; o < 64; o <<= 1) ss += __shfl_xor(ss, o);
            if (lane < 32) pattn[(size_t)row * 32 + lane] = lane == 0 ? ss : 0.f;
        }
    }
    LAS float* tile = (LAS float*)lds;
    int off = 0;
#pragma unroll 1
    for (int l = 0; l < NL; ++l) {
        unsigned char* wl = ws + WS_W + (size_t)l * W_LAYER;
        convert_T(tile, (bf16_t*)(wl + WO_IN), DM, DINP, DIN, P->attn_norm + l * DM, ColMapIn{P->w_in + (size_t)l * DM * DIN}, bid, G, off);
        convert_T(tile, (bf16_t*)(wl + WO_UQ), 512, NQ, 1152, P->q_norm + l * 512, ColMapUq{P->w_uq + (size_t)l * 512 * 1152}, bid, G, off);
        convert_T(tile, (bf16_t*)(wl + WO_K), 512, 768, 1536, P->kv_norm + l * 512, ColMapKv{P->w_ukv + (size_t)l * 512 * 1536, 0}, bid, G, off);
        convert_T(tile, (bf16_t*)(wl + WO_V), 512, 768, 1536, P->kv_norm + l * 512, ColMapKv{P->w_ukv + (size_t)l * 512 * 1536, 128}, bid, G, off);
        convert_T(tile, (bf16_t*)(wl + WO_OUT), DM, DM, DM, nullptr, ColMapId{P->w_out + (size_t)l * DM * DM}, bid, G, off);
        convert_T(tile, (bf16_t*)(wl + WO_GU), DM, 2 * DFF, DFF, P->ffn_norm + l * DM, ColMapGu{P->w_gate + (size_t)l * DM * DFF, P->w_up + (size_t)l * DM * DFF}, bid, G, off);
        convert_T(tile, (bf16_t*)(wl + WO_DN), DFF, DM, DM, nullptr, ColMapId{P->w_down + (size_t)l * DFF * DM}, bid, G, off);
    }
    {
        float* cosr = WSPTR(float, WS_COSR); float* sinr = WSPTR(float, WS_SINR); float* cosm = WSPTR(float, WS_COSM); float* sinm = WSPTR(float, WS_SINM);
        const int* pos = P->pos;
        for (int i = bid * 512 + tid; i < S * 96; i += G * 512) {
            const int s = i / 96, j = i % 96;
            const float ps = (float)pos[s];
            float inv; if (j < 64) inv = 1.0f / powf(10000.f, (float)(2 * j) / 128.f); else inv = 1.0f / powf(10000.f, (float)(2 * (j - 64)) / 64.f);
            const float ang = ps * inv;
            const double a = (double)ang; const double nrev = rint(a * 0.15915494309189535); const float red = (float)(a - nrev * 6.283185307179586);
            const float c = cosf(red), sn = sinf(red);
            if (j < 64) { cosr[s * 64 + j] = c; sinr[s * 64 + j] = sn; } else { cosm[s * 32 + j - 64] = c; sinm[s * 32 + j - 64] = sn; }
        }
    }
}

DI void phase_A(LAS unsigned char* lds, int l) {
    CParams* P = params_opaque(); unsigned char* ws = P->ws; const int bid = blockIdx.x, G = gridDim.x;
    pg8::Gemm g{WSPTR(bf16_t, WS_XB), (const bf16_t*)(ws + WS_W + (size_t)l * W_LAYER + WO_IN), S, DINP, DM, DM, DM}; pg8::StaticOrder so; so.init(S, DINP, G, bid);
    EpiIn E{WSPTR(bf16_t, WS_Z), WSPTR(float, WS_PATTN), WSPTR(float, WS_PCQ), WSPTR(float, WS_PCKV), WSPTR(float, WS_COSR), WSPTR(float, WS_SINR), WSPTR(float, WS_COSM), WSPTR(float, WS_SINM)};
    pg8::gemm_phase(lds, g, so, E);
}
DI void phase_B1(LAS unsigned char* lds, int l) {
    CParams* P = params_opaque(); unsigned char* ws = P->ws; const int bid = blockIdx.x, G = gridDim.x;
    float* ssq_cq = WSPTR(float, WS_PCQ);
    pg8::Gemm g{WSPTR(bf16_t, WS_Z) + Z_CQ, (const bf16_t*)(ws + WS_W + (size_t)l * W_LAYER + WO_UQ), S, NQ, 512, DINP, 512}; pg8::StaticOrder so; so.init(S, NQ, G, bid);
    EpiQ E{WSPTR(bf16_t, WS_MQ), ssq_cq, WSPTR(float, WS_COSM), WSPTR(float, WS_SINM)}; pg8::gemm_phase(lds, g, so, E);
}
DI void phase_B2(LAS unsigned char* lds, int l) {
    CParams* P = params_opaque(); unsigned char* ws = P->ws; const int bid = blockIdx.x, G = gridDim.x;
    float* ssq_ckv = WSPTR(float, WS_PCKV);
    pg8::Gemm g{WSPTR(bf16_t, WS_Z) + Z_CKV, (const bf16_t*)(ws + WS_W + (size_t)l * W_LAYER + WO_K), S, NKV, 512, DINP, 512}; pg8::StaticOrder so; so.init(S, NKV, G, (bid + 64) % G);
    EpiRowScale E{WSPTR(bf16_t, WS_KN), NKV, ssq_ckv, 1.f / 512.f}; pg8::gemm_phase(lds, g, so, E);
}
DI void phase_B3(LAS unsigned char* lds, int l) {
    CParams* P = params_opaque(); unsigned char* ws = P->ws; const int bid = blockIdx.x, G = gridDim.x;
    float* ssq_ckv = WSPTR(float, WS_PCKV);
    pg8::Gemm g{(const bf16_t*)(ws + WS_W + (size_t)l * W_LAYER + WO_V), WSPTR(bf16_t, WS_Z) + Z_CKV, NKV, S, 512, 512, DINP}; pg8::StaticOrder so; so.init(NKV, S, G, (bid + 128) % G);
    EpiColScale E{WSPTR(bf16_t, WS_VT), S, ssq_ckv, 1.f / 512.f}; pg8::gemm_phase(lds, g, so, E);
}
DI void phase_B4(LAS unsigned char* lds, int l) {
    CParams* P = params_opaque(); unsigned char* ws = P->ws;
    volatile LAS unsigned* slot = (volatile LAS unsigned*)(lds + LDS_BYTES - 8);
    unsigned* counter = (unsigned*)(ws + WS_SSQ) + 3840 + l * 64;
    for (;;) {
        __syncthreads();
        if (threadIdx.x == 0) *slot = atomicAdd(counter, 1u);
        __syncthreads();
        const int u = (int)*slot;
        if (u >= 640) break;
        if (u < 384) ret_kv_unit(lds, u / 6, u % 6, WSPTR(bf16_t, WS_Z), WSPTR(float, WS_KVT));
        else { const int v = u - 384; gmlp_unit(lds, v >> 2, v & 3, WSPTR(bf16_t, WS_Z), P->w_s + (size_t)l * 4 * 16384, P->b_s + l * 512, P->gv_norm + l * 512, P->mix_norm + l * DM, WSPTR(bf16_t, WS_Y)); }
    }
}
DI void phase_C(LAS unsigned char* lds, int l) {
    CParams* P = params_opaque(); unsigned char* ws = P->ws; const int bid = blockIdx.x, G = gridDim.x;
    {
        const int tid = tid_opaque(); const float* kvT = WSPTR(float, WS_KVT); bf16_t* prevT = WSPTR(bf16_t, WS_PREVT);
        for (int e = bid * 512 + tid; e < 6 * 16384; e += G * 512) {
            const int h = e >> 14, ed = e & 16383;
            const float decay = __expf(ret_log_gamma(h) * 128.f);
            float st = 0.f;
            for (int n = 0; n < 64; ++n) { const size_t idx = ((size_t)(n * 6 + h) << 14) + ed; prevT[idx] = (bf16_t)f2bf(st); st = decay * st + kvT[idx]; }
        }
    }
    {
        volatile LAS unsigned* slot = (volatile LAS unsigned*)(lds + LDS_BYTES - 8);
        unsigned* counter = (unsigned*)(ws + WS_SSQ) + 3584 + l * 64;
        float* apart = WSPTR(float, WS_APART);
        for (;;) {
            __syncthreads();
            if (threadIdx.x == 0) *slot = atomicAdd(counter, 1u);
            __syncthreads();
            const int u = (int)*slot;
            if (u >= 480) break;
            const int h = u % 6; const unsigned e = ATT_UNITS[u / 6];
            const int qb = e & 31, s0 = (e >> 5) & 255, s1 = (e >> 13) & 255, rec = (int)(e >> 21);
            float* part = rec ? apart + (size_t)(h * 72 + rec - 1) * APART_REC : nullptr;
            attn_unit(lds, h, qb, s0, s1, part, WSPTR(bf16_t, WS_MQ), WSPTR(bf16_t, WS_KN), WSPTR(bf16_t, WS_Z), WSPTR(bf16_t, WS_VT), P->mix_norm + l * DM, WSPTR(bf16_t, WS_Y));
        }
    }
}
DI void phase_D(LAS unsigned char* lds, int l) {
    CParams* P = params_opaque(); unsigned char* ws = P->ws; const int bid = blockIdx.x, G = gridDim.x;
    {
        const int tid = tid_opaque(), gw = bid * 8 + (tid >> 6), lane = tid & 63; const float* apart = WSPTR(float, WS_APART);
        const int nw = G * 8, gsh = (gw + nw - (nw >> 1)) % nw;
        for (int j = gsh; j < 1152; j += nw) { const int w = j & 7, t = j >> 3, h = t / 24, qb = 8 + t % 24, k = (qb + 8) >> 3;
            const int base = qb < 16 ? (qb - 8) * 2 : qb < 24 ? 16 + (qb - 16) * 3 : 40 + (qb - 24) * 4;
            attn_combine_wave(apart + (size_t)(h * 72 + base) * APART_REC + (size_t)w * 34 * 64, k, h, 256 * qb + 32 * w, lane, P->mix_norm + l * DM, WSPTR(bf16_t, WS_Y)); }
    }
    for (int u = bid; u < 384; u += G) ret_out_unit(lds, u / 6, u % 6, WSPTR(bf16_t, WS_Z), WSPTR(bf16_t, WS_PREVT), P->mix_norm + l * DM, WSPTR(bf16_t, WS_Y));
}
DI void phase_E(LAS unsigned char* lds, int l) {
    CParams* P = params_opaque(); unsigned char* ws = P->ws; const int bid = blockIdx.x, G = gridDim.x;
    pg8::Gemm g{WSPTR(bf16_t, WS_Y), (const bf16_t*)(ws + WS_W + (size_t)l * W_LAYER + WO_OUT), S, DM, DM, DM, DM}; pg8::StaticOrder so; so.init(S, DM, G, bid);
    EpiResid E{WSPTR(bf16_t, WS_XB), WSPTR(float, WS_PFFN)};
    pg8::gemm_phase(lds, g, so, E);
}
DI void phase_F(LAS unsigned char* lds, int l) {
    CParams* P = params_opaque(); unsigned char* ws = P->ws; const int bid = blockIdx.x, G = gridDim.x;
    pg8::Gemm g{WSPTR(bf16_t, WS_XB), (const bf16_t*)(ws + WS_W + (size_t)l * W_LAYER + WO_GU), S, 2 * DFF, DM, DM, DM}; pg8::StaticOrder so; so.init(S, 2 * DFF, G, bid);
    EpiGLU E{WSPTR(bf16_t, WS_HID), WSPTR(float, WS_PFFN)};
    pg8::gemm_phase(lds, g, so, E);
}
DI void phase_G(LAS unsigned char* lds, int l) {
    CParams* P = params_opaque(); unsigned char* ws = P->ws; const int bid = blockIdx.x, G = gridDim.x;
    pg8::Gemm g{WSPTR(bf16_t, WS_HID), (const bf16_t*)(ws + WS_W + (size_t)l * W_LAYER + WO_DN), S, DM, DFF, DFF, DFF}; pg8::StaticOrder so; so.init(S, DM, G, bid);
    EpiResid E{WSPTR(bf16_t, WS_XB), WSPTR(float, WS_PATTN)};
    pg8::gemm_phase(lds, g, so, E);
}
DI void phase_final() {
    CParams* P = params_opaque(); unsigned char* ws = P->ws; const int bid = blockIdx.x, G = gridDim.x;
    const int tid = tid_opaque(), wave = tid >> 6, lane = tid & 63;
    const float* sf = WSPTR(float, WS_PATTN); const bf16_t* xb = WSPTR(bf16_t, WS_XB); const float* fn = P->final_norm; float* out = P->out;
    for (int row = bid * 8 + wave; row < S; row += G * 8) {
        float tot = sf[(size_t)row * 32 + (lane & 31)];
#pragma unroll
        for (int o = 1; o < 32; o <<= 1) tot += __shfl_xor(tot, o);
        const float rs = rsqrtf(tot * (1.f / DM) + EPS);
#pragma unroll
        for (int j = 0; j < 8; ++j) { const int c = 4 * lane + 256 * j; const u32x2 v = *(const u32x2*)(xb + (size_t)row * DM + c); const f32x4 gn = *(const f32x4*)(fn + c);
            f32x4 o; o[0] = bflo(v.x) * rs * gn[0]; o[1] = bfhi(v.x) * rs * gn[1]; o[2] = bflo(v.y) * rs * gn[2]; o[3] = bfhi(v.y) * rs * gn[3];
            *(f32x4*)(out + (size_t)row * DM + c) = o; }
    }
}

__global__ void __launch_bounds__(512, 2) fwd_megakernel(Params Pbyval) {
    extern __shared__ __attribute__((aligned(16))) unsigned char smem[];
    LAS unsigned char* lds = (LAS unsigned char*)smem;
    cg::grid_group grid = cg::this_grid();
    volatile LAS unsigned* bst = (volatile LAS unsigned*)(lds + LDS_BYTES - 16);
    if (threadIdx.x < 4) bst[threadIdx.x] = 0u;
    __syncthreads();
    { CParams* P = params_opaque(); (void)xcd_barrier_post((unsigned*)(P->ws + WS_SSQ), bst); }
#define GSYNC() do { CParams* Pb_ = params_opaque(); XcdBarrier b_; b_.bar = (unsigned*)(Pb_->ws + WS_SSQ); b_.x = xb_xcc_id(); b_.st = (volatile LAS unsigned*)(lds + LDS_BYTES - 16); xcd_barrier(b_); } while (0)
    phase_prologue(lds);
    asm volatile("s_waitcnt vmcnt(0) lgkmcnt(0)" ::: "memory"); grid.sync();
#pragma unroll 1
    for (int l = 0; l < NL; ++l) {
        phase_A(lds, l);
        GSYNC();
        phase_B1(lds, l); phase_B2(lds, l); phase_B3(lds, l); phase_B4(lds, l);
        GSYNC();
        phase_C(lds, l);
        GSYNC();
        phase_D(lds, l);
        GSYNC();
        phase_E(lds, l);
        GSYNC();
        phase_F(lds, l);
        GSYNC();
        phase_G(lds, l);
        GSYNC();
    }
    phase_final();
}

extern "C" void kernel_launch(void* const* d_in, const int* in_sizes, int n_in, void* d_out, int out_size, void* d_ws, size_t ws_size, hipStream_t stream) {
    static int grid_blocks = 0;
    if (grid_blocks == 0) {
        if (n_in != 18 || out_size != S * DM || ws_size < WS_END) { fprintf(stderr, "kernel_launch: unexpected problem (n_in %d out %d ws %zu need %zu)\n", n_in, out_size, ws_size, (size_t)WS_END); grid_blocks = -1; return; }
        int dev = 0, cus = 0, per_cu = 0;
        hipGetDevice(&dev);
        hipDeviceGetAttribute(&cus, hipDeviceAttributeMultiprocessorCount, dev);
        hipFuncSetAttribute((const void*)fwd_megakernel, hipFuncAttributeMaxDynamicSharedMemorySize, LDS_BYTES);
        hipOccupancyMaxActiveBlocksPerMultiprocessor(&per_cu, (const void*)fwd_megakernel, 512, LDS_BYTES);
        if (per_cu < 1) { fprintf(stderr, "kernel_launch: occupancy query returned %d\n", per_cu); per_cu = 1; }
        grid_blocks = cus * per_cu;
    }
    if (grid_blocks < 0) return;
    Params p{};
    p.x = (const float*)d_in[0]; p.pos = (const int*)d_in[1]; p.attn_norm = (const float*)d_in[2]; p.w_in = (const float*)d_in[3]; p.q_norm = (const float*)d_in[4];
    p.w_uq = (const float*)d_in[5]; p.kv_norm = (const float*)d_in[6]; p.w_ukv = (const float*)d_in[7]; p.gv_norm = (const float*)d_in[8]; p.w_s = (const float*)d_in[9];
    p.b_s = (const float*)d_in[10]; p.mix_norm = (const float*)d_in[11]; p.w_out = (const float*)d_in[12]; p.ffn_norm = (const float*)d_in[13]; p.w_gate = (const float*)d_in[14];
    p.w_up = (const float*)d_in[15]; p.w_down = (const float*)d_in[16]; p.final_norm = (const float*)d_in[17]; p.out = (float*)d_out; p.ws = (unsigned char*)d_ws;
    if (hipMemsetAsync((char*)d_ws + WS_SSQ, 0, 16384, stream) != hipSuccess) { fprintf(stderr, "kernel_launch: memset of barrier words failed\n"); return; }
    void* args[] = {&p};
    hipError_t e = hipLaunchCooperativeKernel((const void*)fwd_megakernel, dim3(grid_blocks), dim3(512), args, LDS_BYTES, stream);
    if (e != hipSuccess) fprintf(stderr, "cooperative launch failed: %s (grid %d)\n", hipGetErrorString(e), grid_blocks);
}
```

```cpp
#include <hip/hip_runtime.h>
#include <hip/hip_cooperative_groups.h>
#include <cstdint>
#include <cstdio>
namespace cg = cooperative_groups;

#define LAS __attribute__((address_space(3)))
#define DI __device__ __forceinline__
typedef unsigned short bf16_t;
typedef short bf16x8 __attribute__((ext_vector_type(8)));
typedef short s16x4 __attribute__((ext_vector_type(4)));
typedef float f32x4 __attribute__((ext_vector_type(4)));
typedef float f32x16 __attribute__((ext_vector_type(16)));
typedef unsigned u32x4 __attribute__((ext_vector_type(4)));
typedef unsigned u32x2 __attribute__((ext_vector_type(2)));

constexpr int S = 8192, DM = 2048, NL = 4, DIN = 5184, DINP = 5376, DFF = 5632, NQ = 1280, NKV = 768;
constexpr int Z_RQ = 0, Z_RK = 768, Z_RV = 1536, Z_RG = 2304, Z_CQ = 3072, Z_CKV = 3584, Z_GU = 4096, Z_GV = 4608, Z_KPE = 5120;
constexpr float EPS = 1e-6f;
constexpr float QSCALE = 0.07216878364870322f * 1.4426950408889634f;
constexpr float KSCALE_RET = 0.08838834764831845f;

constexpr size_t MiB = 1u << 20;
constexpr size_t WS_SSQ = 0;
constexpr size_t WS_COSR = 1 * MiB, WS_SINR = 3 * MiB, WS_COSM = 5 * MiB, WS_SINM = 6 * MiB;
constexpr size_t WS_W = 8 * MiB, W_LAYER = 98 * MiB;
constexpr size_t WO_IN = 0, WO_UQ = 21 * MiB, WO_K = 21 * MiB + 1280 * 1024, WO_V = WO_K + 768 * 1024, WO_OUT = 23 * MiB + 768 * 1024, WO_GU = WO_OUT + 8 * MiB, WO_DN = WO_GU + 44 * MiB;
static_assert(WO_DN + 22 * MiB <= W_LAYER, "weights layer");
constexpr size_t WS_XRES = WS_W + 4 * W_LAYER;
constexpr size_t WS_XB = WS_XRES + 64 * MiB;
constexpr size_t WS_Z = WS_XB + 32 * MiB;
constexpr size_t WS_MQ = WS_Z + 84 * MiB;
constexpr size_t WS_HID = WS_Z;
constexpr size_t WS_KN = WS_MQ + 20 * MiB;
constexpr size_t WS_VT = WS_KN + 12 * MiB;
constexpr size_t WS_Y = WS_VT + 12 * MiB;
constexpr size_t WS_KVT = WS_Y + 32 * MiB;
constexpr size_t WS_PREVT = WS_KVT + 24 * MiB;
constexpr size_t WS_PATTN = WS_PREVT + 12 * MiB;
constexpr size_t WS_PFFN = WS_PATTN + 1 * MiB;
constexpr size_t WS_PCQ = WS_PFFN + 1 * MiB;
constexpr size_t WS_PCKV = WS_PCQ + 1 * MiB;
constexpr size_t WS_APART = WS_PCKV + 1 * MiB;
constexpr size_t APART_REC = 8 * 34 * 64;
constexpr size_t WS_END = WS_APART + 56 * MiB;
static_assert((size_t)S * DFF * 2 <= 104 * MiB, "hid overlay");
static_assert(432 * APART_REC * 4 <= 56 * MiB, "attention partials");

constexpr int LDS_BYTES = 147456;

struct Params {
    const float* x; const int* pos; const float* attn_norm; const float* w_in; const float* q_norm; const float* w_uq; const float* kv_norm; const float* w_ukv;
    const float* gv_norm; const float* w_s; const float* b_s; const float* mix_norm; const float* w_out; const float* ffn_norm; const float* w_gate; const float* w_up;
    const float* w_down; const float* final_norm; float* out; unsigned char* ws;
};

DI unsigned f2bf(float f) { unsigned u = __builtin_bit_cast(unsigned, f); return (u + 0x7fffu + ((u >> 16) & 1u)) >> 16; }
typedef float f32x2_t __attribute__((ext_vector_type(2))); typedef __bf16 bf16x2_t __attribute__((ext_vector_type(2)));
DI unsigned pk2(float lo, float hi) { const f32x2_t v = {lo, hi}; const bf16x2_t b = __builtin_convertvector(v, bf16x2_t); return __builtin_bit_cast(unsigned, b); }
DI float max3f(float a, float b, float c) { float r; asm("v_max3_f32 %0, %1, %2, %3" : "=v"(r) : "v"(a), "v"(b), "v"(c)); return r; }
DI float half_max(float m) { auto rr = __builtin_amdgcn_permlane32_swap(__float_as_uint(m), __float_as_uint(m), false, false); return fmaxf(__uint_as_float(rr[0]), __uint_as_float(rr[1])); }
DI float half_sum(float m) { auto rr = __builtin_amdgcn_permlane32_swap(__float_as_uint(m), __float_as_uint(m), false, false); return __uint_as_float(rr[0]) + __uint_as_float(rr[1]); }
DI float bf2f(unsigned short b) { return __builtin_bit_cast(float, (unsigned)b << 16); }
DI float bflo(unsigned w) { return __builtin_bit_cast(float, w << 16); }
DI float bfhi(unsigned w) { return __builtin_bit_cast(float, w & 0xffff0000u); }
DI float gelu_tanh(float x) { const float u = 0.7978845608028654f * (x + 0.044715f * x * x * x); const float e = __builtin_amdgcn_exp2f(2.885390081777927f * u); const float t = 1.f - 2.f * __builtin_amdgcn_rcpf(e + 1.f); return 0.5f * x * (1.f + t); }
DI float silu(float x) { return x * __builtin_amdgcn_rcpf(1.f + __builtin_amdgcn_exp2f(-1.4426950408889634f * x)); }
DI int tid_opaque() { int t = threadIdx.x; asm volatile("" : "+v"(t)); return t; }
DI int sgpr_opaque(int v) { asm volatile("" : "+s"(v)); return v; }

namespace pg8 {
constexpr int BM = 256, BK = 64, HALF = 128, HTB = HALF * BK * 2, STAGE_BYTES = 8 * HTB, NXCD = 8, WGM = 8;
__host__ __device__ __forceinline__ int lds_byte(int r, int c) { const int st = (r >> 4) * 2 + (c >> 5), rr = r & 15, cc = c & 31, ob = rr * 64 + cc * 2; return st * 1024 + (ob ^ (((ob >> 9) & 1) << 5)); }
__host__ __device__ __forceinline__ void stage_rc(int b, int& R, int& C) { const int st = b / 1024, sb = b % 1024, swz = sb ^ (((sb >> 9) & 1) << 5); R = (st >> 1) * 16 + swz / 64; C = (st & 1) * 32 + (swz % 64) / 2; }
__host__ __device__ __forceinline__ int perm32(int rho) { const int n = rho >> 4, i = rho & 15; return 8 * (i >> 2) + 4 * n + (i & 3); }
struct Unit { int pm, pn; };
struct Gemm { const bf16_t* A; const bf16_t* Bt; int M, N, K, lda, ldb; };
struct StaticOrder {
    int nM, nN, nwg, G, c;
    __device__ void init(int M, int N, int G_, int c_) { nM = M / BM; nN = N / BM; nwg = nM * nN; G = G_; c = c_; }
    __device__ bool next(int i, Unit& u) const {
        const long L = (long)i * G + c; if (L >= nwg) return false;
        int wgid = (int)L; { const int q = nwg / NXCD, r = nwg % NXCD, xcd = wgid % NXCD, off = wgid / NXCD; wgid = (xcd < r ? xcd * (q + 1) : r * (q + 1) + (xcd - r) * q) + off; }
        const int nig = WGM * nN, gid = wgid / nig, fm = gid * WGM, gsz = (nM - fm) < WGM ? (nM - fm) : WGM;
        u.pm = fm + ((wgid % nig) % gsz); u.pn = (wgid % nig) / gsz; return true;
    }
};

template <class Epi>
__device__ __forceinline__ void gemm_phase(LAS unsigned char* lds, const Gemm g, const StaticOrder& S, const Epi& E) {
    const int tid = tid_opaque(), wid = __builtin_amdgcn_readfirstlane(tid >> 6), lane = tid & 63, wr = wid >> 2, wc = wid & 3, fr = lane & 15, fq = lane >> 4;
    const int K = g.K, nt = K / BK;
    unsigned voffA[2], voffB[2];
#pragma unroll
    for (int i = 0; i < 2; ++i) { int R, C; stage_rc(tid * 16 + i * 8192, R, C); const int Rb = Epi::PERM ? ((R & ~31) + perm32(R & 31)) : R;
        voffA[i] = (unsigned)(R * g.lda + C) * 2u; voffB[i] = (unsigned)(Rb * g.ldb + C) * 2u; }
    const size_t kstep = (size_t)(BK * 2);
    const size_t hstepA = (size_t)HALF * g.lda * 2, hstepB = (size_t)HALF * g.ldb * 2;
    const size_t tstepA = 2 * hstepA, tstepB = 2 * hstepB;
    const unsigned ldsw = (unsigned)wid * 1024u;
    const int aoff = lds_byte(wr * 64 + fr, fq * 8), boff = lds_byte(wc * 32 + fr, fq * 8);
#define PG8_SA(b, h) (((b) * 2 + (h)) * HTB)
#define PG8_SB(b, h) ((4 + (b) * 2 + (h)) * HTB)
#define PG8_STAGE(bufoff, gbase, voff) do { _Pragma("unroll") for (int _i = 0; _i < 2; ++_i) \
        __builtin_amdgcn_global_load_lds((const unsigned*)((const char*)(gbase) + (voff)[_i]), (LAS unsigned*)(lds + (bufoff) + ldsw + _i * 8192), 16, 0, 0); } while (0)
#define PG8_LDA(dst, b, h) do { _Pragma("unroll") for (int m = 0; m < 4; ++m) _Pragma("unroll") for (int k = 0; k < 2; ++k) dst[m][k] = *(const LAS bf16x8*)(lds + PG8_SA(b, h) + aoff + m * 2048 + k * 1024); } while (0)
#define PG8_LDB(dst, b, h) do { _Pragma("unroll") for (int n = 0; n < 2; ++n) _Pragma("unroll") for (int k = 0; k < 2; ++k) dst[n][k] = *(const LAS bf16x8*)(lds + PG8_SB(b, h) + boff + n * 2048 + k * 1024); } while (0)
#define PG8_MMA(ai, bj, At, Bt) do { __builtin_amdgcn_s_setprio(1); _Pragma("unroll") for (int m = 0; m < 4; ++m) _Pragma("unroll") for (int n = 0; n < 2; ++n) _Pragma("unroll") for (int k = 0; k < 2; ++k) \
        acc[ai][bj][m][n] = __builtin_amdgcn_mfma_f32_16x16x32_bf16(Bt[n][k], At[m][k], acc[ai][bj][m][n], 0, 0, 0); __builtin_amdgcn_s_setprio(0); } while (0)
#define PG8_WAIT_V(n) asm volatile("s_waitcnt vmcnt(" #n ")" ::: "memory")
#define PG8_WAIT_L(n) asm volatile("s_waitcnt lgkmcnt(" #n ")" ::: "memory")
#define PG8_BAR __builtin_amdgcn_s_barrier()
#define PG8_SCHED __builtin_amdgcn_sched_barrier(0)
    Unit cur, nxt; int ui = 0;
    if (!S.next(0, cur)) return;
    f32x4 acc[2][2][4][2];
#pragma unroll
    for (int a = 0; a < 2; ++a)
#pragma unroll
        for (int b = 0; b < 2; ++b)
#pragma unroll
            for (int m = 0; m < 4; ++m)
#pragma unroll
                for (int n = 0; n < 2; ++n) acc[a][b][m][n] = (f32x4){0.f, 0.f, 0.f, 0.f};
    bf16x8 At[4][2], B0[2][2], B1[2][2];
    const char* cA = (const char*)g.A + (size_t)cur.pm * tstepA; const char* cB = (const char*)g.Bt + (size_t)cur.pn * tstepB;
    PG8_STAGE(PG8_SB(0, 0), cB, voffB); PG8_STAGE(PG8_SB(0, 1), cB + hstepB, voffB); PG8_STAGE(PG8_SA(0, 0), cA, voffA); PG8_STAGE(PG8_SA(0, 1), cA + hstepA, voffA);
    if (wr == 1) PG8_BAR;
    PG8_WAIT_V(2); PG8_BAR;
    PG8_STAGE(PG8_SB(1, 0), cB + kstep, voffB); PG8_STAGE(PG8_SA(1, 0), cA + kstep, voffA); PG8_STAGE(PG8_SB(1, 1), cB + hstepB + kstep, voffB);
    PG8_WAIT_V(6); PG8_BAR;
    for (;;) {
        const bool has_next = S.next(ui + 1, nxt);
        const char* nA = has_next ? (const char*)g.A + (size_t)nxt.pm * tstepA : cA; const char* nB = has_next ? (const char*)g.Bt + (size_t)nxt.pn * tstepB : cB;
        for (int t = 0; t < nt; t += 2) {
            const bool last = (t == nt - 2);
            const char* a1 = cA + (size_t)(t + 1) * kstep;
            const char* a2 = last ? nA : cA + (size_t)(t + 2) * kstep; const char* b2 = last ? nB : cB + (size_t)(t + 2) * kstep;
            const char* a3 = a2 + kstep; const char* b3 = b2 + kstep;
            PG8_LDB(B0, 0, 0); PG8_LDB(B1, 0, 1); PG8_SCHED; PG8_LDA(At, 0, 0); PG8_STAGE(PG8_SA(1, 1), a1 + hstepA, voffA);
            PG8_WAIT_V(8); PG8_WAIT_L(0); PG8_BAR; PG8_MMA(0, 0, At, B0); PG8_MMA(0, 1, At, B1); PG8_BAR; PG8_SCHED;
            PG8_LDA(At, 0, 1); PG8_STAGE(PG8_SB(0, 0), b2, voffB); PG8_STAGE(PG8_SB(0, 1), b2 + hstepB, voffB); PG8_STAGE(PG8_SA(0, 0), a2, voffA);
            PG8_WAIT_V(8); PG8_WAIT_L(0); PG8_BAR; PG8_MMA(1, 0, At, B0); PG8_MMA(1, 1, At, B1); PG8_BAR; PG8_SCHED;
            PG8_LDB(B0, 1, 0); PG8_LDB(B1, 1, 1); PG8_SCHED; PG8_LDA(At, 1, 0); PG8_STAGE(PG8_SA(0, 1), a2 + hstepA, voffA);
            PG8_WAIT_V(8); PG8_WAIT_L(0); PG8_BAR; PG8_MMA(0, 0, At, B0); PG8_MMA(0, 1, At, B1); PG8_BAR; PG8_SCHED;
            PG8_LDA(At, 1, 1); PG8_STAGE(PG8_SB(1, 0), b3, voffB); PG8_STAGE(PG8_SB(1, 1), b3 + hstepB, voffB); PG8_STAGE(PG8_SA(1, 0), a3, voffA);
            PG8_WAIT_V(8); PG8_WAIT_L(0); PG8_BAR; PG8_MMA(1, 0, At, B0); PG8_MMA(1, 1, At, B1); PG8_BAR; PG8_SCHED;
        }
        if (wr == 0) PG8_BAR;
        E(acc, cur, wr, wc, fr, fq);
        PG8_WAIT_V(0);
        if (!has_next) break;
#pragma unroll
        for (int a = 0; a < 2; ++a)
#pragma unroll
            for (int b = 0; b < 2; ++b)
#pragma unroll
                for (int m = 0; m < 4; ++m)
#pragma unroll
                    for (int n = 0; n < 2; ++n) acc[a][b][m][n] = (f32x4){0.f, 0.f, 0.f, 0.f};
        cur = nxt; cA = nA; cB = nB; ++ui;
        if (wr == 1) PG8_BAR;
    }
    PG8_WAIT_V(0);
    PG8_BAR;
#undef PG8_SA
#undef PG8_SB
#undef PG8_STAGE
#undef PG8_LDA
#undef PG8_LDB
#undef PG8_MMA
#undef PG8_WAIT_V
#undef PG8_WAIT_L
#undef PG8_BAR
#undef PG8_SCHED
}
}

typedef f32x4 Acc[2][2][4][2];
DI u32x4 pack8(const float* v) { u32x4 w; w.x = pk2(v[0], v[1]); w.y = pk2(v[2], v[3]); w.z = pk2(v[4], v[5]); w.w = pk2(v[6], v[7]); return w; }
DI float quad_sum(float s) { s += __shfl_xor(s, 16); s += __shfl_xor(s, 32); return s; }

DI float rowsum32(const float* part, int row, int fq) {
    const f32x4 a = *(const f32x4*)(part + (size_t)row * 32 + 8 * fq), b = *(const f32x4*)(part + (size_t)row * 32 + 8 * fq + 4);
    return quad_sum(((a[0] + a[1]) + (a[2] + a[3])) + ((b[0] + b[1]) + (b[2] + b[3])));
}
DI float rowsum8(const float* part, int row, int fq) {
    const float a = part[(size_t)row * 8 + 2 * fq], b = part[(size_t)row * 8 + 2 * fq + 1];
    return quad_sum(a + b);
}
DI float rowsum8_full(const float* part, int row) {
    const f32x4 a = *(const f32x4*)(part + (size_t)row * 8), b = *(const f32x4*)(part + (size_t)row * 8 + 4);
    return ((a[0] + a[1]) + (a[2] + a[3])) + ((b[0] + b[1]) + (b[2] + b[3]));
}
struct EpiIn {
    static constexpr bool PERM = true;
    bf16_t* z; const float* ssq_in; float* ssq_cq; float* ssq_ckv; const float* cosr; const float* sinr; const float* cosm; const float* sinm;
    DI void operator()(const Acc& acc, const pg8::Unit& u, int wr, int wc, int fr, int fq) const {
        const int pn = u.pn;
        const int mode = pn < 3 ? 0 : pn < 6 ? 1 : pn < 12 ? 2 : pn < 14 ? 3 : pn < 16 ? 4 : pn < 20 ? 5 : 6;
#pragma unroll
        for (int ai = 0; ai < 2; ++ai)
#pragma unroll
            for (int m = 0; m < 4; ++m) {
                const int row = u.pm * 256 + ai * 128 + wr * 64 + m * 16 + fr;
                const float rs = rsqrtf(rowsum32(ssq_in, row, fq) * (1.f / DM) + EPS);
                float ss = 0.f;
#pragma unroll
                for (int bj = 0; bj < 2; ++bj) {
                    const int c0 = pn * 256 + bj * 128 + wc * 32 + 8 * fq;
                    float v[8];
#pragma unroll
                    for (int i = 0; i < 4; ++i) { v[i] = acc[ai][bj][m][0][i] * rs; v[4 + i] = acc[ai][bj][m][1][i] * rs; }
                    if (mode <= 1) {
                        const int d0 = ((c0 & 127) >> 3) * 4;
                        const f32x4 cs = *(const f32x4*)(cosr + (size_t)row * 64 + d0), sn = *(const f32x4*)(sinr + (size_t)row * 64 + d0);
                        const float sc = mode == 1 ? KSCALE_RET : 1.f;
#pragma unroll
                        for (int i = 0; i < 4; ++i) { const float x1 = v[i], x2 = v[4 + i]; v[i] = (x1 * cs[i] - x2 * sn[i]) * sc; v[4 + i] = (x2 * cs[i] + x1 * sn[i]) * sc; }
                    } else if (mode == 3 || mode == 4) {
#pragma unroll
                        for (int i = 0; i < 8; ++i) ss += v[i] * v[i];
                    } else if (mode == 5) {
#pragma unroll
                        for (int i = 0; i < 8; ++i) v[i] = gelu_tanh(v[i]);
                    } else if (mode == 6) {
                        if (c0 < Z_KPE + 64) {
                            const int d0 = ((c0 - Z_KPE) >> 3) * 4;
                            const f32x4 cs = *(const f32x4*)(cosm + (size_t)row * 32 + d0), sn = *(const f32x4*)(sinm + (size_t)row * 32 + d0);
#pragma unroll
                            for (int i = 0; i < 4; ++i) { const float x1 = v[i], x2 = v[4 + i]; v[i] = x1 * cs[i] - x2 * sn[i]; v[4 + i] = x2 * cs[i] + x1 * sn[i]; }
                        }
                    }
                    *(u32x4*)(z + (size_t)row * DINP + c0) = pack8(v);
                }
                if (mode == 3 || mode == 4) { ss = quad_sum(ss); if (fq == 0) (mode == 3 ? ssq_cq : ssq_ckv)[(size_t)row * 8 + (pn & 1) * 4 + wc] = ss; }
            }
    }
};
struct EpiQ {
    static constexpr bool PERM = true;
    bf16_t* mq; const float* ssq; const float* cosm; const float* sinm;
    DI void operator()(const Acc& acc, const pg8::Unit& u, int wr, int wc, int fr, int fq) const {
#pragma unroll
        for (int ai = 0; ai < 2; ++ai)
#pragma unroll
            for (int m = 0; m < 4; ++m) {
                const int row = u.pm * 256 + ai * 128 + wr * 64 + m * 16 + fr;
                const float rs = rsqrtf(rowsum8(ssq, row, fq) * (1.f / 512.f) + EPS) * QSCALE;
#pragma unroll
                for (int bj = 0; bj < 2; ++bj) {
                    const int c0 = u.pn * 256 + bj * 128 + wc * 32 + 8 * fq;
                    float v[8];
#pragma unroll
                    for (int i = 0; i < 4; ++i) { v[i] = acc[ai][bj][m][0][i] * rs; v[4 + i] = acc[ai][bj][m][1][i] * rs; }
                    if (c0 >= 768 && c0 < 1152) {
                        const int d0 = (((c0 - 768) & 63) >> 3) * 4;
                        const f32x4 cs = *(const f32x4*)(cosm + (size_t)row * 32 + d0), sn = *(const f32x4*)(sinm + (size_t)row * 32 + d0);
#pragma unroll
                        for (int i = 0; i < 4; ++i) { const float x1 = v[i], x2 = v[4 + i]; v[i] = x1 * cs[i] - x2 * sn[i]; v[4 + i] = x2 * cs[i] + x1 * sn[i]; }
                    }
                    *(u32x4*)(mq + (size_t)row * NQ + c0) = pack8(v);
                }
            }
    }
};
struct EpiRowScale {
    static constexpr bool PERM = true;
    bf16_t* o; int ldo; const float* ssq; float inv_n;
    DI void operator()(const Acc& acc, const pg8::Unit& u, int wr, int wc, int fr, int fq) const {
#pragma unroll
        for (int ai = 0; ai < 2; ++ai)
#pragma unroll
            for (int m = 0; m < 4; ++m) {
                const int row = u.pm * 256 + ai * 128 + wr * 64 + m * 16 + fr;
                const float rs = rsqrtf(rowsum8(ssq, row, fq) * inv_n + EPS);
#pragma unroll
                for (int bj = 0; bj < 2; ++bj) {
                    const int c0 = u.pn * 256 + bj * 128 + wc * 32 + 8 * fq;
                    float v[8];
#pragma unroll
                    for (int i = 0; i < 4; ++i) { v[i] = acc[ai][bj][m][0][i] * rs; v[4 + i] = acc[ai][bj][m][1][i] * rs; }
                    *(u32x4*)(o + (size_t)row * ldo + c0) = pack8(v);
                }
            }
    }
};
struct EpiColScale {
    static constexpr bool PERM = true;
    bf16_t* o; int ldo; const float* ssq; float inv_n;
    DI void operator()(const Acc& acc, const pg8::Unit& u, int wr, int wc, int fr, int fq) const {
#pragma unroll
        for (int bj = 0; bj < 2; ++bj) {
            const int c0 = u.pn * 256 + bj * 128 + wc * 32 + 8 * fq;
            float rs[8];
#pragma unroll
            for (int i = 0; i < 8; ++i) rs[i] = rsqrtf(rowsum8_full(ssq, c0 + i) * inv_n + EPS);
#pragma unroll
            for (int ai = 0; ai < 2; ++ai)
#pragma unroll
                for (int m = 0; m < 4; ++m) {
                    const int row = u.pm * 256 + ai * 128 + wr * 64 + m * 16 + fr;
                    float v[8];
#pragma unroll
                    for (int i = 0; i < 4; ++i) { v[i] = acc[ai][bj][m][0][i] * rs[i]; v[4 + i] = acc[ai][bj][m][1][i] * rs[4 + i]; }
                    *(u32x4*)(o + (size_t)row * ldo + c0) = pack8(v);
                }
        }
    }
};
struct EpiResid {
    static constexpr bool PERM = true;
    bf16_t* xb; float* ssq_out;
    DI void operator()(const Acc& acc, const pg8::Unit& u, int wr, int wc, int fr, int fq) const {
#pragma unroll
        for (int ai = 0; ai < 2; ++ai)
#pragma unroll
            for (int m = 0; m < 4; ++m) {
                const int row = u.pm * 256 + ai * 128 + wr * 64 + m * 16 + fr;
                float ss = 0.f;
#pragma unroll
                for (int bj = 0; bj < 2; ++bj) {
                    const size_t off = (size_t)row * DM + u.pn * 256 + bj * 128 + wc * 32 + 8 * fq;
                    const u32x4 rw = *(const u32x4*)(xb + off);
                    float o[8];
                    o[0] = bflo(rw.x) + acc[ai][bj][m][0][0]; o[1] = bfhi(rw.x) + acc[ai][bj][m][0][1]; o[2] = bflo(rw.y) + acc[ai][bj][m][0][2]; o[3] = bfhi(rw.y) + acc[ai][bj][m][0][3];
                    o[4] = bflo(rw.z) + acc[ai][bj][m][1][0]; o[5] = bfhi(rw.z) + acc[ai][bj][m][1][1]; o[6] = bflo(rw.w) + acc[ai][bj][m][1][2]; o[7] = bfhi(rw.w) + acc[ai][bj][m][1][3];
                    *(u32x4*)(xb + off) = pack8(o);
#pragma unroll
                    for (int i = 0; i < 8; ++i) ss += o[i] * o[i];
                }
                ss = quad_sum(ss);
                if (fq == 0) ssq_out[(size_t)row * 32 + u.pn * 4 + wc] = ss;
            }
    }
};
struct EpiGLU {
    static constexpr bool PERM = true;
    bf16_t* hid; const float* ssq;
    DI void operator()(const Acc& acc, const pg8::Unit& u, int wr, int wc, int fr, int fq) const {
#pragma unroll
        for (int ai = 0; ai < 2; ++ai)
#pragma unroll
            for (int m = 0; m < 4; ++m) {
                const int row = u.pm * 256 + ai * 128 + wr * 64 + m * 16 + fr;
                const float rs = rsqrtf(rowsum32(ssq, row, fq) * (1.f / DM) + EPS);
                float v[8];
#pragma unroll
                for (int i = 0; i < 4; ++i) {
                    v[i] = silu(acc[ai][0][m][0][i] * rs) * (acc[ai][1][m][0][i] * rs);
                    v[4 + i] = silu(acc[ai][0][m][1][i] * rs) * (acc[ai][1][m][1][i] * rs);
                }
                *(u32x4*)(hid + (size_t)row * DFF + u.pn * 128 + wc * 32 + 8 * fq) = pack8(v);
            }
    }
};

struct ColMapIn { const float* w; DI const float* operator()(int n) const {
    if (n < 1536) { const int p = n & 127, a = p >> 3, i = p & 7; return w + (n - p) + 4 * a + (i & 3) + 64 * (i >> 2); }
    if (n < 4096) return w + n;
    if (n < 5120) return w + n + 64;
    if (n < 5184) { const int p = n - 5120, a = p >> 3, i = p & 7; return w + 4096 + 4 * a + (i & 3) + 32 * (i >> 2); }
    return nullptr; } };
struct ColMapUq { const float* w; DI const float* operator()(int n) const {
    if (n < 768) return w + (n >> 7) * 192 + (n & 127);
    if (n < 1152) { const int q = n - 768, hh = q >> 6, p = q & 63, a = p >> 3, i = p & 7; return w + hh * 192 + 128 + 4 * a + (i & 3) + 32 * (i >> 2); }
    return nullptr; } };
struct ColMapKv { const float* w; int off; DI const float* operator()(int n) const { return w + (n >> 7) * 256 + off + (n & 127); } };
struct ColMapId { const float* w; DI const float* operator()(int n) const { return w + n; } };
struct ColMapGu { const float* wg; const float* wu; DI const float* operator()(int n) const { const int t = n >> 8, r = n & 255; return r < 128 ? wg + t * 128 + r : wu + t * 128 + (r - 128); } };

template <class CM>
DI void convert_T(LAS float* tile, bf16_t* dst, int K, int Nd, int srcN, const float* gain, const CM cm, int bid, int nb, int& off) {
    const int tid = tid_opaque(), n4 = tid & 31, kk = tid >> 5;
    const int nkt = K / 64, nnt = Nd / 128, nitems = nkt * nnt;
    int it = bid - off; if (it < 0) it += nb;
    off = (off + nitems) % nb;
    constexpr int NF = 4;
    f32x4 v[NF][4];
#define CVT_LOAD(f, item_) do { const int k0_ = ((item_) / nnt) * 64, n0_ = ((item_) % nnt) * 128; const float* src_ = cm(n0_ + 4 * n4); \
        _Pragma("unroll") for (int p = 0; p < 4; ++p) { const int k_ = k0_ + kk + 16 * p; \
            if (src_) { v[f][p] = *(const f32x4*)(src_ + (size_t)k_ * srcN); if (gain) { const float g_ = gain[k_]; v[f][p] = v[f][p] * g_; } } else v[f][p] = (f32x4){0.f, 0.f, 0.f, 0.f}; } } while (0)
#define CVT_STORE(f, item_) do { const int k0_ = ((item_) / nnt) * 64, n0_ = ((item_) % nnt) * 128; \
        _Pragma("unroll") for (int p = 0; p < 4; ++p) { const int k_ = kk + 16 * p; *(LAS f32x4*)(tile + k_ * 128 + ((4 * n4) ^ (8 * ((k_ >> 3) & 3)))) = v[f][p]; } \
        __syncthreads(); \
        if ((item_) + NF * nb < nitems) CVT_LOAD(f, (item_) + NF * nb); \
        _Pragma("unroll") for (int q = 0; q < 2; ++q) { const int c = tid & 7, n = (tid >> 3) + 64 * q, nsw = n ^ (8 * (c & 3)); float o[8];     \
            _Pragma("unroll") for (int j = 0; j < 8; ++j) o[j] = tile[(8 * c + j) * 128 + nsw]; \
            *(u32x4*)(dst + (size_t)(n0_ + n) * K + k0_ + 8 * c) = pack8(o); } \
        __syncthreads(); } while (0)
#pragma unroll
    for (int f = 0; f < NF; ++f) if (it + f * nb < nitems) CVT_LOAD(f, it + f * nb);
    for (; it < nitems; it += NF * nb) {
#pragma unroll
        for (int f = 0; f < NF; ++f) if (it + f * nb < nitems) CVT_STORE(f, it + f * nb);
    }
#undef CVT_LOAD
#undef CVT_STORE
}

constexpr int T136 = 136, TILE_B = 128 * T136 * 2;
DI void mm128(const LAS unsigned char* A, const LAS unsigned char* Bt, f32x4 (&acc)[8], int w, int fr, int fq) {
#pragma unroll
    for (int ks = 0; ks < 4; ++ks) {
        const bf16x8 a = *(const LAS bf16x8*)(A + ((16 * w + fr) * T136 + 32 * ks + 8 * fq) * 2);
#pragma unroll
        for (int nb = 0; nb < 8; ++nb) {
            const bf16x8 b = *(const LAS bf16x8*)(Bt + ((16 * nb + fr) * T136 + 32 * ks + 8 * fq) * 2);
            acc[nb] = __builtin_amdgcn_mfma_f32_16x16x32_bf16(b, a, acc[nb], 0, 0, 0);
        }
    }
}
DI void stage_rows(int tid, LAS unsigned char* T, const bf16_t* g, size_t ld) {
#pragma unroll
    for (int p = 0; p < 4; ++p) { const int q = tid + 512 * p, r = q >> 4, c = q & 15; *(LAS u32x4*)(T + (r * T136 + 8 * c) * 2) = *(const u32x4*)(g + (size_t)r * ld + 8 * c); }
}
DI void tile_load(int tid, u32x4 (&v)[4], const bf16_t* g, size_t ld) {
    const int r = tid & 127;
#pragma unroll
    for (int p = 0; p < 4; ++p) v[p] = *(const u32x4*)(g + (size_t)r * ld + 8 * ((tid >> 7) + 4 * p));
}
DI void tile_store_T(int tid, LAS unsigned char* T, const u32x4 (&v)[4], const LAS float* rowscale, const float* colgain) {
    const int r = tid & 127;
    const float rs = rowscale ? rowscale[r] : 1.f;
#pragma unroll
    for (int p = 0; p < 4; ++p) {
        const int cc = (tid >> 7) + 4 * p;
        const unsigned w[4] = {v[p].x, v[p].y, v[p].z, v[p].w};
#pragma unroll
        for (int j = 0; j < 4; ++j) {
            const int c0 = 8 * cc + 2 * j;
            float a = bflo(w[j]) * rs, b = bfhi(w[j]) * rs;
            if (colgain) { a *= colgain[c0]; b *= colgain[c0 + 1]; }
            *(LAS unsigned short*)(T + ((c0) * T136 + r) * 2) = (unsigned short)f2bf(a);
            *(LAS unsigned short*)(T + ((c0 + 1) * T136 + r) * 2) = (unsigned short)f2bf(b);
        }
    }
}

DI float ret_log_gamma(int h) {
    return h == 0 ? -3.1748698315e-02f : h == 1 ? -1.5748356968e-02f : h == 2 ? -7.8431774610e-03f : h == 3 ? -3.9138993211e-03f : h == 4 ? -1.9550348358e-03f : -9.7703964783e-04f; }

DI void ret_kv_unit(LAS unsigned char* lds, int n, int h, const bf16_t* z, float* kvT) {
    const int tid = tid_opaque(), w = tid >> 6, lane = tid & 63, fr = lane & 15, fq = lane >> 4;
    LAS unsigned char* TA = lds; LAS unsigned char* TB = lds + TILE_B; LAS float* dec = (LAS float*)(lds + 2 * TILE_B);
    const float lg = ret_log_gamma(h);
    const bf16_t* zr = z + (size_t)n * 128 * DINP;
    u32x4 vv[4], kk[4];
    tile_load(tid, vv, zr + Z_RV + h * 128, DINP); tile_load(tid, kk, zr + Z_RK + h * 128, DINP);
    __syncthreads();
    if (tid < 128) dec[tid] = __expf(lg * (127.f - (float)tid));
    __syncthreads();
    tile_store_T(tid, TA, vv, nullptr, nullptr);
    tile_store_T(tid, TB, kk, dec, nullptr);
    __syncthreads();
    f32x4 acc[8];
#pragma unroll
    for (int i = 0; i < 8; ++i) acc[i] = (f32x4){0.f, 0.f, 0.f, 0.f};
    mm128(TA, TB, acc, w, fr, fq);
    float* o = kvT + ((size_t)(n * 6 + h) * 128 + 16 * w + fr) * 128 + 4 * fq;
#pragma unroll
    for (int nb = 0; nb < 8; ++nb) *(f32x4*)(o + 16 * nb) = acc[nb];
}

DI void ret_out_unit(LAS unsigned char* lds, int n, int h, const bf16_t* z, const bf16_t* prevT, const float* mixg, bf16_t* y) {
    const int tid = tid_opaque(), w = tid >> 6, lane = tid & 63, fr = lane & 15, fq = lane >> 4;
    LAS unsigned char* TQ = lds; LAS unsigned char* TK = lds + TILE_B; LAS unsigned char* TS = lds + 2 * TILE_B; LAS unsigned char* TP = lds + 3 * TILE_B;
    const float lg = ret_log_gamma(h);
    const bf16_t* zr = z + (size_t)n * 128 * DINP;
    u32x4 vv[4];
    tile_load(tid, vv, zr + Z_RV + h * 128, DINP);
    u32x2 gwv[8];
#pragma unroll
    for (int nb = 0; nb < 8; ++nb) gwv[nb] = *(const u32x2*)(zr + (size_t)(16 * w + fr) * DINP + Z_RG + h * 128 + 16 * nb + 4 * fq);
    __syncthreads();
    stage_rows(tid, TQ, zr + Z_RQ + h * 128, DINP);
    stage_rows(tid, TK, zr + Z_RK + h * 128, DINP);
    stage_rows(tid, TP, prevT + (size_t)(n * 6 + h) * 16384, 128);
    __syncthreads();
    f32x4 acc[8];
#pragma unroll
    for (int i = 0; i < 8; ++i) acc[i] = (f32x4){0.f, 0.f, 0.f, 0.f};
    mm128(TQ, TK, acc, w, fr, fq);
    const int irow = 16 * w + fr;
#pragma unroll
    for (int nb = 0; nb < 8; ++nb) {
        float v[4];
#pragma unroll
        for (int i = 0; i < 4; ++i) { const int j = 16 * nb + 4 * fq + i; const int rel = irow - j; v[i] = rel >= 0 ? acc[nb][i] * __expf(lg * (float)rel) : 0.f; }
        u32x2 wv; wv.x = pk2(v[0], v[1]); wv.y = pk2(v[2], v[3]);
        *(LAS u32x2*)(TS + (irow * T136 + 16 * nb + 4 * fq) * 2) = wv;
    }
    __syncthreads();
    tile_store_T(tid, TK, vv, nullptr, nullptr);
    __syncthreads();
    f32x4 a1[8], a2[8];
#pragma unroll
    for (int i = 0; i < 8; ++i) { a1[i] = (f32x4){0.f, 0.f, 0.f, 0.f}; a2[i] = (f32x4){0.f, 0.f, 0.f, 0.f}; }
    mm128(TS, TK, a1, w, fr, fq);
    mm128(TQ, TP, a2, w, fr, fq);
    const float qd = __expf(lg * (float)(irow + 1));
    float ss = 0.f;
#pragma unroll
    for (int nb = 0; nb < 8; ++nb)
#pragma unroll
        for (int i = 0; i < 4; ++i) { const float o = a1[nb][i] + qd * a2[nb][i]; a1[nb][i] = o; ss += o * o; }
    ss = quad_sum(ss);
    const float rs = rsqrtf(ss * (1.f / 128.f) + EPS);
    const size_t tok = (size_t)n * 128 + irow;
#pragma unroll
    for (int nb = 0; nb < 8; ++nb) {
        const int e0 = 16 * nb + 4 * fq;
        const u32x2 gw = gwv[nb];
        const f32x4 mg = *(const f32x4*)(mixg + h * 128 + e0);
        const float g0 = silu(bflo(gw.x)), g1 = silu(bfhi(gw.x)), g2 = silu(bflo(gw.y)), g3 = silu(bfhi(gw.y));
        u32x2 o; o.x = pk2(a1[nb][0] * rs * mg[0] * g0, a1[nb][1] * rs * mg[1] * g1); o.y = pk2(a1[nb][2] * rs * mg[2] * g2, a1[nb][3] * rs * mg[3] * g3);
        *(u32x2*)(y + tok * DM + h * 128 + e0) = o;
    }
}

DI void gmlp_unit(LAS unsigned char* lds, int n, int g, const bf16_t* z, const float* w_s, const float* b_s, const float* vgain, const float* mixg, bf16_t* y) {
    const int tid = tid_opaque(), w = tid >> 6, lane = tid & 63, fr = lane & 15, fq = lane >> 4;
    LAS unsigned char* TA = lds; LAS unsigned char* TB = lds + TILE_B; LAS float* part = (LAS float*)(lds + 2 * TILE_B); LAS float* rstd = part + 512;
    const bf16_t* zr = z + (size_t)n * 128 * DINP;
    __syncthreads();
    u32x4 vv[4];
    tile_load(tid, vv, zr + Z_GV + g * 128, DINP);
    {
        const int r = tid & 127; float ss = 0.f;
#pragma unroll
        for (int p = 0; p < 4; ++p) { const unsigned wv[4] = {vv[p].x, vv[p].y, vv[p].z, vv[p].w};
#pragma unroll
            for (int j = 0; j < 4; ++j) { const float a = bflo(wv[j]), b = bfhi(wv[j]); ss += a * a + b * b; } }
        part[(tid >> 7) * 128 + r] = ss;
    }
    __syncthreads();
    if (tid < 128) rstd[tid] = rsqrtf((part[tid] + part[128 + tid] + part[256 + tid] + part[384 + tid]) * (1.f / 128.f) + EPS);
    {
        const float* ws = w_s + (size_t)g * 16384;
#pragma unroll
        for (int p = 0; p < 8; ++p) { const int q = tid + 512 * p, t = q >> 5, s0 = (q & 31) * 4; const f32x4 v = *(const f32x4*)(ws + t * 128 + s0);
            u32x2 o; o.x = pk2(s0 <= t ? v[0] : 0.f, s0 + 1 <= t ? v[1] : 0.f); o.y = pk2(s0 + 2 <= t ? v[2] : 0.f, s0 + 3 <= t ? v[3] : 0.f);
            *(LAS u32x2*)(TA + (t * T136 + s0) * 2) = o; }
    }
    __syncthreads();
    tile_store_T(tid, TB, vv, rstd, vgain + g * 128);
    __syncthreads();
    f32x4 acc[8];
#pragma unroll
    for (int i = 0; i < 8; ++i) acc[i] = (f32x4){0.f, 0.f, 0.f, 0.f};
    mm128(TA, TB, acc, w, fr, fq);
    const int t = 16 * w + fr; const size_t tok = (size_t)n * 128 + t;
    const float bias = b_s[g * 128 + t];
    float ss = 0.f;
#pragma unroll
    for (int nb = 0; nb < 8; ++nb) {
        const u32x2 uw = *(const u32x2*)(z + tok * DINP + Z_GU + g * 128 + 16 * nb + 4 * fq);
        const float u0 = bflo(uw.x), u1 = bfhi(uw.x), u2 = bflo(uw.y), u3 = bfhi(uw.y);
        acc[nb][0] = u0 * (acc[nb][0] + bias); acc[nb][1] = u1 * (acc[nb][1] + bias); acc[nb][2] = u2 * (acc[nb][2] + bias); acc[nb][3] = u3 * (acc[nb][3] + bias);
        ss += (acc[nb][0] * acc[nb][0] + acc[nb][1] * acc[nb][1]) + (acc[nb][2] * acc[nb][2] + acc[nb][3] * acc[nb][3]);
    }
    ss = quad_sum(ss);
    const float rs = rsqrtf(ss * (1.f / 128.f) + EPS);
#pragma unroll
    for (int nb = 0; nb < 8; ++nb) {
        const int c0 = 1536 + g * 128 + 16 * nb + 4 * fq;
        const f32x4 mg = *(const f32x4*)(mixg + c0);
        u32x2 o; o.x = pk2(acc[nb][0] * rs * mg[0], acc[nb][1] * rs * mg[1]); o.y = pk2(acc[nb][2] * rs * mg[2], acc[nb][3] * rs * mg[3]);
        *(u32x2*)(y + tok * DM + c0) = o;
    }
}

constexpr int KSTR = 400, VSTR = 136, ABUF = 45056, AV_OFF = 25600;
__device__ const unsigned ATT_UNITS[80] = {0x8a4001fu, 0x8c8041fu, 0x8ec081fu, 0x9100c1fu, 0x4c40017u, 0x4e80417u, 0x50c0817u, 0x1e4000fu, 0x208040fu, 0x40007u, 0x823e01eu, 0x847c3feu, 0x86ba7deu, 0x88f8bbeu, 0x463e016u, 0x487c3f6u, 0x7a3c01du, 0x7c783ddu, 0x7eb479du, 0x80f0b5du, 0x4ab87d6u, 0x403c015u, 0x1a3c00eu, 0x1c783ceu, 0x723a01cu, 0x74743bcu, 0x76ae75cu, 0x78e8afcu, 0x42763d5u, 0x44b0775u, 0x6a3801bu, 0x6c7039bu, 0x6ea871bu, 0x70e0a9bu, 0x3a38014u, 0x3c70394u, 0x3ea8714u, 0x163800du, 0x187038du, 0x38006u, 0x623601au, 0x646c37au, 0x66a26dau, 0x68d8a3au, 0x3436013u, 0x366c373u, 0x5a34019u, 0x5c68359u, 0x5e9c699u, 0x60d09d9u, 0x38a06d3u, 0x2e34012u, 0x123400cu, 0x146834cu, 0x5232018u, 0x5464338u, 0x5696658u, 0x58c8978u, 0x3066352u, 0x3298672u, 0x2830011u, 0x2a60311u, 0x2c90611u, 0xe3000bu, 0x106030bu, 0x30005u, 0x222e010u, 0x245c2f0u, 0x26885d0u, 0xa2c00au, 0xc582cau, 0x628009u, 0x850289u, 0x28004u, 0x224008u, 0x448248u, 0x20003u, 0x18002u, 0x10001u, 0x8000u};
DI void attn_finish(f32x16 (&o)[4], float l, int h, int qrow, int hi, const float* mixg, bf16_t* y) {
    const float inv = __builtin_amdgcn_rcpf(l);
    float ss = 0.f;
#pragma unroll
    for (int i = 0; i < 4; ++i)
#pragma unroll
        for (int r = 0; r < 16; ++r) { const float v = o[i][r] * inv; o[i][r] = v; ss += v * v; }
    ss = half_sum(ss);
    const float rs = rsqrtf(ss * (1.f / 128.f) + EPS);
    bf16_t* yr = y + (size_t)qrow * DM + 768 + 128 * h;
    const float* mg = mixg + 768 + 128 * h;
#pragma unroll
    for (int db = 0; db < 4; ++db)
#pragma unroll
        for (int gq = 0; gq < 4; ++gq) {
            const int d0 = 32 * db + 8 * gq + 4 * hi;
            const f32x4 gg = *(const f32x4*)(mg + d0);
            u32x2 ov; ov.x = pk2(o[db][4 * gq] * rs * gg[0], o[db][4 * gq + 1] * rs * gg[1]); ov.y = pk2(o[db][4 * gq + 2] * rs * gg[2], o[db][4 * gq + 3] * rs * gg[3]);
            *(u32x2*)(yr + d0) = ov;
        }
}
DI void attn_combine_wave(const float* rec, int k, int h, int qrow0, int lane, const float* mixg, bf16_t* y) {
    const int r32 = lane & 31, hi = lane >> 5;
    float mt = -1e30f;
    for (int i = 0; i < k; ++i) mt = fmaxf(mt, rec[(size_t)i * APART_REC + 32 * 64 + lane]);
    f32x16 o[4];
#pragma unroll
    for (int i = 0; i < 4; ++i)
#pragma unroll
        for (int r = 0; r < 16; ++r) o[i][r] = 0.f;
    float lt = 0.f;
#pragma unroll 1
    for (int i = 0; i < k; ++i) {
        const float* ri = rec + (size_t)i * APART_REC; const unsigned* rw = (const unsigned*)ri;
        const float a = __builtin_amdgcn_exp2f(ri[32 * 64 + lane] - mt);
        lt += ri[33 * 64 + lane] * a;
        unsigned wv[32];
#pragma unroll
        for (int q = 0; q < 32; ++q) wv[q] = rw[q * 64 + lane];
#pragma unroll
        for (int d = 0; d < 4; ++d)
#pragma unroll
            for (int r = 0; r < 16; r += 2) { const unsigned w = wv[d * 8 + (r >> 1)]; o[d][r] += bflo(w) * a; o[d][r + 1] += bfhi(w) * a; }
    }
    attn_finish(o, lt, h, qrow0 + r32, hi, mixg, y);
}
DI void attn_unit(LAS unsigned char* lds, int h, int qb, int s_begin, int s_end, float* part, const bf16_t* mq, const bf16_t* kn, const bf16_t* z, const bf16_t* vt, const float* mixg, bf16_t* y) {
    const int tid = tid_opaque(), w = tid >> 6, lane = tid & 63, r32 = lane & 31, hi = lane >> 5;
    const int q0 = 256 * qb + 32 * w;
    bf16x8 qf[12];
    {
        const bf16_t* qr = mq + (size_t)(q0 + r32) * NQ;
#pragma unroll
        for (int ks = 0; ks < 8; ++ks) qf[ks] = *(const bf16x8*)(qr + 128 * h + 16 * ks + 8 * hi);
#pragma unroll
        for (int ks = 0; ks < 4; ++ks) qf[8 + ks] = *(const bf16x8*)(qr + 768 + 64 * h + 16 * ks + 8 * hi);
    }
    f32x16 o[4];
#pragma unroll
    for (int i = 0; i < 4; ++i)
#pragma unroll
        for (int r = 0; r < 16; ++r) o[i][r] = 0.f;
    float mrow = -1e30f, lrow = 0.f;
    u32x4 kreg[3], vreg[2];
    const bf16_t* knsrc = kn + (size_t)(tid >> 4) * NKV + 128 * h + 8 * (tid & 15);
    const bf16_t* kpsrc = z + (size_t)(tid >> 3) * DINP + Z_KPE + 8 * (tid & 7);
    const bf16_t* vsrc = vt + (size_t)(128 * h + (tid >> 3)) * S + 8 * (tid & 7);
    const int kndst = (tid >> 4) * KSTR + (tid & 15) * 16, kpdst = (tid >> 3) * KSTR + 256 + (tid & 7) * 16;
    const int vdst = AV_OFF + (tid >> 3) * VSTR + (tid & 7) * 16;
#define ATT_LOAD(step_) do { const size_t k0_ = (size_t)64 * (step_); \
        kreg[0] = *(const u32x4*)(knsrc + k0_ * NKV); kreg[1] = *(const u32x4*)(knsrc + (k0_ + 32) * NKV); kreg[2] = *(const u32x4*)(kpsrc + k0_ * DINP); \
        vreg[0] = *(const u32x4*)(vsrc + k0_); vreg[1] = *(const u32x4*)(vsrc + (size_t)64 * S + k0_); } while (0)
#define ATT_STORE(buf_) do { LAS unsigned char* b_ = lds + (buf_) * ABUF; \
        *(LAS u32x4*)(b_ + kndst) = kreg[0]; *(LAS u32x4*)(b_ + kndst + 32 * KSTR) = kreg[1]; *(LAS u32x4*)(b_ + kpdst) = kreg[2]; \
        *(LAS u32x2*)(b_ + vdst) = (u32x2){vreg[0].x, vreg[0].y}; *(LAS u32x2*)(b_ + vdst + 8) = (u32x2){vreg[0].z, vreg[0].w}; \
        *(LAS u32x2*)(b_ + vdst + 64 * VSTR) = (u32x2){vreg[1].x, vreg[1].y}; *(LAS u32x2*)(b_ + vdst + 64 * VSTR + 8) = (u32x2){vreg[1].z, vreg[1].w}; } while (0)
    ATT_LOAD(s_begin);
    ATT_STORE(0);
    if (s_begin + 1 < s_end) ATT_LOAD(s_begin + 1);
    __syncthreads();
    for (int step = s_begin; step < s_end; ++step) {
        const int cur = (step - s_begin) & 1;
        if (step + 1 < s_end) { ATT_STORE(cur ^ 1); if (step + 2 < s_end) ATT_LOAD(step + 2); }
        const int jd = step - 4 * qb;
        if (!(jd >= 0 && 64 * jd > 32 * w + 31)) {
            const LAS unsigned char* kt = lds + cur * ABUF;
            f32x16 p0, p1;
#pragma unroll
            for (int r = 0; r < 16; ++r) { p0[r] = 0.f; p1[r] = 0.f; }
            const LAS unsigned char* kb0 = kt + r32 * KSTR + 16 * hi;
            const LAS unsigned char* vb0 = kt + AV_OFF + r32 * VSTR + 8 * hi;
#define ATT_SCHED __builtin_amdgcn_sched_barrier(0)
#define KLOAD(dst, b_) do { _Pragma("unroll") for (int j = 0; j < 2; ++j) { dst[j][0] = *(const LAS bf16x8*)(kb0 + 32 * (2 * (b_) + j)); dst[j][1] = *(const LAS bf16x8*)(kb0 + 32 * KSTR + 32 * (2 * (b_) + j)); } } while (0)
#define KMMA(src, b_) do { _Pragma("unroll") for (int j = 0; j < 2; ++j) { p0 = __builtin_amdgcn_mfma_f32_32x32x16_bf16(src[j][0], qf[2 * (b_) + j], p0, 0, 0, 0); p1 = __builtin_amdgcn_mfma_f32_32x32x16_bf16(src[j][1], qf[2 * (b_) + j], p1, 0, 0, 0); } } while (0)
#define VLOAD(dst, db_) do { _Pragma("unroll") for (int kb = 0; kb < 2; ++kb) _Pragma("unroll") for (int s = 0; s < 2; ++s) { const LAS unsigned char* vp = vb0 + (db_) * 32 * VSTR + (32 * kb + 16 * s) * 2; \
                const s16x4 lo = *(const LAS s16x4*)vp, hi4 = *(const LAS s16x4*)(vp + 16); dst[2 * kb + s] = __builtin_shufflevector(lo, hi4, 0, 1, 2, 3, 4, 5, 6, 7); } } while (0)
#define VMMA(src, db_) do { _Pragma("unroll") for (int i = 0; i < 4; ++i) o[db_] = __builtin_amdgcn_mfma_f32_32x32x16_bf16(src[i], pf[i], o[db_], 0, 0, 0); } while (0)
            {
                bf16x8 kA[2][2], kB[2][2];
                KLOAD(kA, 0); ATT_SCHED;
                KLOAD(kB, 1); ATT_SCHED; KMMA(kA, 0); ATT_SCHED;
                KLOAD(kA, 2); ATT_SCHED; KMMA(kB, 1); ATT_SCHED;
                KLOAD(kB, 3); ATT_SCHED; KMMA(kA, 2); ATT_SCHED;
                KLOAD(kA, 4); ATT_SCHED; KMMA(kB, 3); ATT_SCHED;
                KLOAD(kB, 5); ATT_SCHED; KMMA(kA, 4); ATT_SCHED;
                KMMA(kB, 5); ATT_SCHED;
            }
            bf16x8 vA[4], vB[4];
            VLOAD(vA, 0); ATT_SCHED;
            if (jd >= 0) {
                const int qrel = 32 * w + r32;
#pragma unroll
                for (int r = 0; r < 16; ++r) { const int kr = 64 * jd + (r & 3) + 8 * (r >> 2) + 4 * hi; if (kr > qrel) p0[r] = -INFINITY; if (kr + 32 > qrel) p1[r] = -INFINITY; }
            }
            float mx = fmaxf(p0[0], p1[0]), mx2 = fmaxf(p0[1], p1[1]);
#pragma unroll
            for (int r = 2; r < 16; r += 2) { mx = max3f(mx, p0[r], p1[r]); mx2 = max3f(mx2, p0[r + 1], p1[r + 1]); }
            mx = fmaxf(mx, mx2);
            mx = half_max(mx);
            if (__any(mx > mrow + 8.f)) {
                const float mnew = fmaxf(mrow, mx);
                const float alpha = __builtin_amdgcn_exp2f(mrow - mnew);
                lrow *= alpha; mrow = mnew;
#pragma unroll
                for (int i = 0; i < 4; ++i)
#pragma unroll
                    for (int r = 0; r < 16; ++r) o[i][r] *= alpha;
            }
            float ls = 0.f;
#pragma unroll
            for (int r = 0; r < 16; ++r) { p0[r] = __builtin_amdgcn_exp2f(p0[r] - mrow); p1[r] = __builtin_amdgcn_exp2f(p1[r] - mrow); ls += p0[r] + p1[r]; }
            lrow += ls;
            bf16x8 pf[4];
#pragma unroll
            for (int s = 0; s < 2; ++s) {
                u32x4 a, b;
                a.x = pk2(p0[8 * s + 0], p0[8 * s + 1]); a.y = pk2(p0[8 * s + 2], p0[8 * s + 3]); a.z = pk2(p0[8 * s + 4], p0[8 * s + 5]); a.w = pk2(p0[8 * s + 6], p0[8 * s + 7]);
                b.x = pk2(p1[8 * s + 0], p1[8 * s + 1]); b.y = pk2(p1[8 * s + 2], p1[8 * s + 3]); b.z = pk2(p1[8 * s + 4], p1[8 * s + 5]); b.w = pk2(p1[8 * s + 6], p1[8 * s + 7]);
                pf[s] = __builtin_bit_cast(bf16x8, a); pf[2 + s] = __builtin_bit_cast(bf16x8, b);
            }
            ATT_SCHED;
            VLOAD(vB, 1); ATT_SCHED; VMMA(vA, 0); ATT_SCHED;
            VLOAD(vA, 2); ATT_SCHED; VMMA(vB, 1); ATT_SCHED;
            VLOAD(vB, 3); ATT_SCHED; VMMA(vA, 2); ATT_SCHED;
            VMMA(vB, 3); ATT_SCHED;
#undef KLOAD
#undef KMMA
#undef VLOAD
#undef VMMA
#undef ATT_SCHED
        }
        __syncthreads();
    }
#undef ATT_LOAD
#undef ATT_STORE
    lrow = half_sum(lrow);
    if (part) {
        float* rec = part + (size_t)w * 34 * 64; unsigned* rw = (unsigned*)rec;
#pragma unroll
        for (int i = 0; i < 4; ++i)
#pragma unroll
            for (int r = 0; r < 16; r += 2) rw[(i * 8 + (r >> 1)) * 64 + lane] = pk2(o[i][r], o[i][r + 1]);
        rec[32 * 64 + lane] = mrow; rec[33 * 64 + lane] = lrow;
    } else attn_finish(o, lrow, h, q0 + r32, hi, mixg, y);
}

#define XB_TMO      128
#define XB_XCNT(j)  (256  + 64 * (j))
#define XB_XSUB(j)  (1280 + 64 * (j))
#define XB_XGEN(j)  (2304 + 64 * (j))
#define XB_TOP      3328
#define XB_TOPGEN   3392
#define XCD_BAR_WORDS 3456
#define XB_SPIN_CAP (1u << 20)
DI unsigned xb_ld(unsigned* p)              { return __hip_atomic_load(p, __ATOMIC_RELAXED, __HIP_MEMORY_SCOPE_AGENT); }
DI unsigned xb_add(unsigned* p, unsigned v) { return __hip_atomic_fetch_add(p, v, __ATOMIC_RELAXED, __HIP_MEMORY_SCOPE_AGENT); }
DI unsigned xb_xcc_id() { return (unsigned)__builtin_amdgcn_s_getreg((3 << 11) | 20) & 0xFu; }
#define XB_SPIN(cond, bar) do { unsigned _sp = 0; while (cond) { __builtin_amdgcn_s_sleep(1); \
    if ((++_sp & 255u) == 0u) { if (xb_ld(&(bar)[XB_TMO])) break; if (_sp > XB_SPIN_CAP) { atomicAdd(&(bar)[XB_TMO], 1u); break; } } } } while (0)
struct XcdBarrier { unsigned* bar; unsigned x; volatile LAS unsigned* st; };
DI XcdBarrier xcd_barrier_post(unsigned* bar, volatile LAS unsigned* st) {
    XcdBarrier b; b.bar = bar; b.x = xb_xcc_id(); b.st = st;
    if (threadIdx.x == 0) (void)xb_add(&bar[XB_XCNT(b.x)], 1u);
    return b;
}
DI void xcd_barrier_complete(unsigned* bar, unsigned x, unsigned& nloc, unsigned& nx) {
    const unsigned G = gridDim.x * gridDim.y * gridDim.z;
    unsigned sum, cnt, mine, sp = 0u;
    for (;;) {
        sum = 0u; cnt = 0u; mine = 0u;
#pragma unroll
        for (unsigned j = 0; j < 16; ++j) { const unsigned c = xb_ld(&bar[XB_XCNT(j)]); sum += c; cnt += (c > 0u) ? 1u : 0u; mine = (j == x) ? c : mine; }
        if (sum == G) break;
        __builtin_amdgcn_s_sleep(1);
        if ((++sp & 255u) == 0u) { if (xb_ld(&bar[XB_TMO])) break; if (sp > XB_SPIN_CAP) { atomicAdd(&bar[XB_TMO], 1u); break; } }
    }
    nloc = mine > 0u ? mine : 1u; nx = cnt > 0u ? cnt : 1u;
}
DI void xcd_barrier(const XcdBarrier& b) {
    asm volatile("s_waitcnt vmcnt(0)" ::: "memory");
    __syncthreads();
    if (threadIdx.x == 0) {
        unsigned* bar = b.bar;
        __builtin_amdgcn_s_waitcnt(0);
        unsigned nloc = b.st[0], nx = b.st[1];
        if (nloc == 0u) { xcd_barrier_complete(bar, b.x, nloc, nx); b.st[0] = nloc; b.st[1] = nx; }
        const unsigned old = xb_add(&bar[XB_XSUB(b.x)], 1u);
        const unsigned gen = old / nloc;
        if (old + 1u == (gen + 1u) * nloc) {
            __builtin_amdgcn_fence(__ATOMIC_RELEASE, "agent");
            asm volatile("s_waitcnt vmcnt(0)" ::: "memory");
            const unsigned og = xb_add(&bar[XB_TOP], 1u);
            const unsigned tg = og / nx;
            if (og + 1u == (tg + 1u) * nx) xb_add(&bar[XB_TOPGEN], 1u);
            else XB_SPIN(xb_ld(&bar[XB_TOPGEN]) == tg, bar);
            __builtin_amdgcn_fence(__ATOMIC_ACQUIRE, "agent");
            xb_add(&bar[XB_XGEN(b.x)], 1u);
            asm volatile("s_waitcnt vmcnt(0)" ::: "memory");
        } else {
            XB_SPIN(xb_ld(&bar[XB_XGEN(b.x)]) == gen, bar);
            __builtin_amdgcn_fence(__ATOMIC_ACQUIRE, "agent");
            asm volatile("s_waitcnt vmcnt(0)" ::: "memory");
        }
    }
    __syncthreads();
}

typedef const Params __attribute__((address_space(4))) CParams;
DI CParams* params_opaque() { unsigned long long p = (unsigned long long)__builtin_amdgcn_kernarg_segment_ptr(); asm volatile("" : "+s"(p)); return (CParams*)p; }
#define WSPTR(T, off) ((T*)(ws + (off)))

DI void phase_prologue(LAS unsigned char* lds) {
    CParams* P = params_opaque();
    const int tid = tid_opaque(), bid = blockIdx.x, G = gridDim.x, wave = tid >> 6, lane = tid & 63;
    unsigned char* ws = P->ws;
    float* pattn = WSPTR(float, WS_PATTN);
    {
        const float* x = P->x; bf16_t* xb = WSPTR(bf16_t, WS_XB);
        for (int row = bid * 8 + wave; row < S; row += G * 8) {
            const float* xr = x + (size_t)row * DM; float ss = 0.f;
#pragma unroll
            for (int j = 0; j < 8; ++j) { const f32x4 v = *(const f32x4*)(xr + 4 * lane + 256 * j); ss += (v[0] * v[0] + v[1] * v[1]) + (v[2] * v[2] + v[3] * v[3]);
                u32x2 o; o.x = pk2(v[0], v[1]); o.y = pk2(v[2], v[3]); *(u32x2*)(xb + (size_t)row * DM + 4 * lane + 256 * j) = o; }
#pragma unroll
            for (int o = 1; o < 64; o <<= 1) ss += __shfl_xor(ss, o);
            if (lane < 32) pattn[(size_t)row * 32 + lane] = lane == 0 ? ss : 0.f;
        }
    }
    LAS float* tile = (LAS float*)lds;
    int off = 0;
#pragma unroll 1
    for (int l = 0; l < NL; ++l) {
        unsigned char* wl = ws + WS_W + (size_t)l * W_LAYER;
        convert_T(tile, (bf16_t*)(wl + WO_IN), DM, DINP, DIN, P->attn_norm + l * DM, ColMapIn{P->w_in + (size_t)l * DM * DIN}, bid, G, off);
        convert_T(tile, (bf16_t*)(wl + WO_UQ), 512, NQ, 1152, P->q_norm + l * 512, ColMapUq{P->w_uq + (size_t)l * 512 * 1152}, bid, G, off);
        convert_T(tile, (bf16_t*)(wl + WO_K), 512, 768, 1536, P->kv_norm + l * 512, ColMapKv{P->w_ukv + (size_t)l * 512 * 1536, 0}, bid, G, off);
        convert_T(tile, (bf16_t*)(wl + WO_V), 512, 768, 1536, P->kv_norm + l * 512, ColMapKv{P->w_ukv + (size_t)l * 512 * 1536, 128}, bid, G, off);
        convert_T(tile, (bf16_t*)(wl + WO_OUT), DM, DM, DM, nullptr, ColMapId{P->w_out + (size_t)l * DM * DM}, bid, G, off);
        convert_T(tile, (bf16_t*)(wl + WO_GU), DM, 2 * DFF, DFF, P->ffn_norm + l * DM, ColMapGu{P->w_gate + (size_t)l * DM * DFF, P->w_up + (size_t)l * DM * DFF}, bid, G, off);
        convert_T(tile, (bf16_t*)(wl + WO_DN), DFF, DM, DM, nullptr, ColMapId{P->w_down + (size_t)l * DFF * DM}, bid, G, off);
    }
    {
        float* cosr = WSPTR(float, WS_COSR); float* sinr = WSPTR(float, WS_SINR); float* cosm = WSPTR(float, WS_COSM); float* sinm = WSPTR(float, WS_SINM);
        const int* pos = P->pos;
        for (int i = bid * 512 + tid; i < S * 96; i += G * 512) {
            const int s = i / 96, j = i % 96;
            const float ps = (float)pos[s];
            float inv; if (j < 64) inv = 1.0f / powf(10000.f, (float)(2 * j) / 128.f); else inv = 1.0f / powf(10000.f, (float)(2 * (j - 64)) / 64.f);
            const float ang = ps * inv;
            const double a = (double)ang; const double nrev = rint(a * 0.15915494309189535); const float red = (float)(a - nrev * 6.283185307179586);
            const float c = cosf(red), sn = sinf(red);
            if (j < 64) { cosr[s * 64 + j] = c; sinr[s * 64 + j] = sn; } else { cosm[s * 32 + j - 64] = c; sinm[s * 32 + j - 64] = sn; }
        }
    }
}

DI void phase_A(LAS unsigned char* lds, int l) {
    CParams* P = params_opaque(); unsigned char* ws = P->ws; const int bid = blockIdx.x, G = gridDim.x;
    pg8::Gemm g{WSPTR(bf16_t, WS_XB), (const bf16_t*)(ws + WS_W + (size_t)l * W_LAYER + WO_IN), S, DINP, DM, DM, DM}; pg8::StaticOrder so; so.init(S, DINP, G, bid);
    EpiIn E{WSPTR(bf16_t, WS_Z), WSPTR(float, WS_PATTN), WSPTR(float, WS_PCQ), WSPTR(float, WS_PCKV), WSPTR(float, WS_COSR), WSPTR(float, WS_SINR), WSPTR(float, WS_COSM), WSPTR(float, WS_SINM)};
    pg8::gemm_phase(lds, g, so, E);
}
DI void phase_B1(LAS unsigned char* lds, int l) {
    CParams* P = params_opaque(); unsigned char* ws = P->ws; const int bid = blockIdx.x, G = gridDim.x;
    float* ssq_cq = WSPTR(float, WS_PCQ);
    pg8::Gemm g{WSPTR(bf16_t, WS_Z) + Z_CQ, (const bf16_t*)(ws + WS_W + (size_t)l * W_LAYER + WO_UQ), S, NQ, 512, DINP, 512}; pg8::StaticOrder so; so.init(S, NQ, G, bid);
    EpiQ E{WSPTR(bf16_t, WS_MQ), ssq_cq, WSPTR(float, WS_COSM), WSPTR(float, WS_SINM)}; pg8::gemm_phase(lds, g, so, E);
}
DI void phase_B2(LAS unsigned char* lds, int l) {
    CParams* P = params_opaque(); unsigned char* ws = P->ws; const int bid = blockIdx.x, G = gridDim.x;
    float* ssq_ckv = WSPTR(float, WS_PCKV);
    pg8::Gemm g{WSPTR(bf16_t, WS_Z) + Z_CKV, (const bf16_t*)(ws + WS_W + (size_t)l * W_LAYER + WO_K), S, NKV, 512, DINP, 512}; pg8::StaticOrder so; so.init(S, NKV, G, (bid + 64) % G);
    EpiRowScale E{WSPTR(bf16_t, WS_KN), NKV, ssq_ckv, 1.f / 512.f}; pg8::gemm_phase(lds, g, so, E);
}
DI void phase_B3(LAS unsigned char* lds, int l) {
    CParams* P = params_opaque(); unsigned char* ws = P->ws; const int bid = blockIdx.x, G = gridDim.x;
    float* ssq_ckv = WSPTR(float, WS_PCKV);
    pg8::Gemm g{(const bf16_t*)(ws + WS_W + (size_t)l * W_LAYER + WO_V), WSPTR(bf16_t, WS_Z) + Z_CKV, NKV, S, 512, 512, DINP}; pg8::StaticOrder so; so.init(NKV, S, G, (bid + 128) % G);
    EpiColScale E{WSPTR(bf16_t, WS_VT), S, ssq_ckv, 1.f / 512.f}; pg8::gemm_phase(lds, g, so, E);
}
DI void phase_B4(LAS unsigned char* lds, int l) {
    CParams* P = params_opaque(); unsigned char* ws = P->ws;
    volatile LAS unsigned* slot = (volatile LAS unsigned*)(lds + LDS_BYTES - 8);
    unsigned* counter = (unsigned*)(ws + WS_SSQ) + 3840 + l * 64;
    for (;;) {
        __syncthreads();
        if (threadIdx.x == 0) *slot = atomicAdd(counter, 1u);
        __syncthreads();
        const int u = (int)*slot;
        if (u >= 640) break;
        if (u < 384) ret_kv_unit(lds, u / 6, u % 6, WSPTR(bf16_t, WS_Z), WSPTR(float, WS_KVT));
        else { const int v = u - 384; gmlp_unit(lds, v >> 2, v & 3, WSPTR(bf16_t, WS_Z), P->w_s + (size_t)l * 4 * 16384, P->b_s + l * 512, P->gv_norm + l * 512, P->mix_norm + l * DM, WSPTR(bf16_t, WS_Y)); }
    }
}
DI void phase_C(LAS unsigned char* lds, int l) {
    CParams* P = params_opaque(); unsigned char* ws = P->ws; const int bid = blockIdx.x, G = gridDim.x;
    {
        const int tid = tid_opaque(); const float* kvT = WSPTR(float, WS_KVT); bf16_t* prevT = WSPTR(bf16_t, WS_PREVT);
        for (int e = bid * 512 + tid; e < 6 * 16384; e += G * 512) {
            const int h = e >> 14, ed = e & 16383;
            const float decay = __expf(ret_log_gamma(h) * 128.f);
            float st = 0.f;
            for (int n = 0; n < 64; ++n) { const size_t idx = ((size_t)(n * 6 + h) << 14) + ed; prevT[idx] = (bf16_t)f2bf(st); st = decay * st + kvT[idx]; }
        }
    }
    {
        volatile LAS unsigned* slot = (volatile LAS unsigned*)(lds + LDS_BYTES - 8);
        unsigned* counter = (unsigned*)(ws + WS_SSQ) + 3584 + l * 64;
        float* apart = WSPTR(float, WS_APART);
        for (;;) {
            __syncthreads();
            if (threadIdx.x == 0) *slot = atomicAdd(counter, 1u);
            __syncthreads();
            const int u = (int)*slot;
            if (u >= 480) break;
            const int h = u % 6; const unsigned e = ATT_UNITS[u / 6];
            const int qb = e & 31, s0 = (e >> 5) & 255, s1 = (e >> 13) & 255, rec = (int)(e >> 21);
            float* part = rec ? apart + (size_t)(h * 72 + rec - 1) * APART_REC : nullptr;
            attn_unit(lds, h, qb, s0, s1, part, WSPTR(bf16_t, WS_MQ), WSPTR(bf16_t, WS_KN), WSPTR(bf16_t, WS_Z), WSPTR(bf16_t, WS_VT), P->mix_norm + l * DM, WSPTR(bf16_t, WS_Y));
        }
    }
}
DI void phase_D(LAS unsigned char* lds, int l) {
    CParams* P = params_opaque(); unsigned char* ws = P->ws; const int bid = blockIdx.x, G = gridDim.x;
    {
        const int tid = tid_opaque(), gw = bid * 8 + (tid >> 6), lane = tid & 63; const float* apart = WSPTR(float, WS_APART);
        const int nw = G * 8, gsh = (gw + nw - (nw >> 1)) % nw;
        for (int j = gsh; j < 1152; j += nw) { const int w = j & 7, t = j >> 3, h = t / 24, qb = 8 + t % 24, k = (qb + 8) >> 3;
            const int base = qb < 16 ? (qb - 8) * 2 : qb < 24 ? 16 + (qb - 16) * 3 : 40 + (qb - 24) * 4;
            attn_combine_wave(apart + (size_t)(h * 72 + base) * APART_REC + (size_t)w * 34 * 64, k, h, 256 * qb + 32 * w, lane, P->mix_norm + l * DM, WSPTR(bf16_t, WS_Y)); }
    }
    for (int u = bid; u < 384; u += G) ret_out_unit(lds, u / 6, u % 6, WSPTR(bf16_t, WS_Z), WSPTR(bf16_t, WS_PREVT), P->mix_norm + l * DM, WSPTR(bf16_t, WS_Y));
}
DI void phase_E(LAS unsigned char* lds, int l) {
    CParams* P = params_opaque(); unsigned char* ws = P->ws; const int bid = blockIdx.x, G = gridDim.x;
    pg8::Gemm g{WSPTR(bf16_t, WS_Y), (const bf16_t*)(ws + WS_W + (size_t)l * W_LAYER + WO_OUT), S, DM, DM, DM, DM}; pg8::StaticOrder so; so.init(S, DM, G, bid);
    EpiResid E{WSPTR(bf16_t, WS_XB), WSPTR(float, WS_PFFN)};
    pg8::gemm_phase(lds, g, so, E);
}
DI void phase_F(LAS unsigned char* lds, int l) {
    CParams* P = params_opaque(); unsigned char* ws = P->ws; const int bid = blockIdx.x, G = gridDim.x;
    pg8::Gemm g{WSPTR(bf16_t, WS_XB), (const bf16_t*)(ws + WS_W + (size_t)l * W_LAYER + WO_GU), S, 2 * DFF, DM, DM, DM}; pg8::StaticOrder so; so.init(S, 2 * DFF, G, bid);
    EpiGLU E{WSPTR(bf16_t, WS_HID), WSPTR(float, WS_PFFN)};
    pg8::gemm_phase(lds, g, so, E);
}
DI void phase_G(LAS unsigned char* lds, int l) {
    CParams* P = params_opaque(); unsigned char* ws = P->ws; const int bid = blockIdx.x, G = gridDim.x;
    pg8::Gemm g{WSPTR(bf16_t, WS_HID), (const bf16_t*)(ws + WS_W + (size_t)l * W_LAYER + WO_DN), S, DM, DFF, DFF, DFF}; pg8::StaticOrder so; so.init(S, DM, G, bid);
    EpiResid E{WSPTR(bf16_t, WS_XB), WSPTR(float, WS_PATTN)};
    pg8::gemm_phase(lds, g, so, E);
}
DI void phase_final() {
    CParams* P = params_opaque(); unsigned char* ws = P->ws; const int bid = blockIdx.x, G = gridDim.x;
    const int tid = tid_opaque(), wave = tid >> 6, lane = tid & 63;
    const float* sf = WSPTR(float, WS_PATTN); const bf16_t* xb = WSPTR(bf16_t, WS_XB); const float* fn = P->final_norm; float* out = P->out;
    for (int row = bid * 8 + wave; row < S; row += G * 8) {
        float tot = sf[(size_t)row * 32 + (lane & 31)];
#pragma unroll
        for (int o = 1; o < 32; o <<= 1) tot += __shfl_xor(tot, o);
        const float rs = rsqrtf(tot * (1.f / DM) + EPS);
#pragma unroll
        for (int j = 0; j < 8; ++j) { const int c = 4 * lane + 256 * j; const u32x2 v = *(const u32x2*)(xb + (size_t)row * DM + c); const f32x4 gn = *(const f32x4*)(fn + c);
            f32x4 o; o[0] = bflo(v.x) * rs * gn[0]; o[1] = bfhi(v.x) * rs * gn[1]; o[2] = bflo(v.y) * rs * gn[2]; o[3] = bfhi(v.y) * rs * gn[3];
            *(f32x4*)(out + (size_t)row * DM + c) = o; }
    }
}

__global__ void __launch_bounds__(512, 2) fwd_megakernel(Params Pbyval) {
    extern __shared__ __attribute__((aligned(16))) unsigned char smem[];
    LAS unsigned char* lds = (LAS unsigned char*)smem;
    cg::grid_group grid = cg::this_grid();
    volatile LAS unsigned* bst = (volatile LAS unsigned*)(lds + LDS_BYTES - 16);
    if (threadIdx.x < 4) bst[threadIdx.x] = 0u;
    __syncthreads();
    if (blockIdx.x == 0) { CParams* P = params_opaque(); unsigned* cw = (unsigned*)(P->ws + WS_SSQ);
        for (int i = threadIdx.x; i < 4096; i += 512) cw[i] = 0u; }
#define GSYNC() do { CParams* Pb_ = params_opaque(); XcdBarrier b_; b_.bar = (unsigned*)(Pb_->ws + WS_SSQ); b_.x = xb_xcc_id(); b_.st = (volatile LAS unsigned*)(lds + LDS_BYTES - 16); xcd_barrier(b_); } while (0)
    phase_prologue(lds);
    asm volatile("s_waitcnt vmcnt(0) lgkmcnt(0)" ::: "memory"); grid.sync();
    { CParams* P = params_opaque(); (void)xcd_barrier_post((unsigned*)(P->ws + WS_SSQ), bst); }
#pragma unroll 1
    for (int l = 0; l < NL; ++l) {
        phase_A(lds, l);
        GSYNC();
        phase_B1(lds, l); phase_B2(lds, l); phase_B3(lds, l); phase_B4(lds, l);
        GSYNC();
        phase_C(lds, l);
        GSYNC();
        phase_D(lds, l);
        GSYNC();
        phase_E(lds, l);
        GSYNC();
        phase_F(lds, l);
        GSYNC();
        phase_G(lds, l);
        GSYNC();
    }
    phase_final();
}

extern "C" void kernel_launch(void* const* d_in, const int* in_sizes, int n_in, void* d_out, int out_size, void* d_ws, size_t ws_size, hipStream_t stream) {
    static int grid_blocks = 0;
    if (grid_blocks == 0) {
        if (n_in != 18 || out_size != S * DM || ws_size < WS_END) { fprintf(stderr, "kernel_launch: unexpected problem (n_in %d out %d ws %zu need %zu)\n", n_in, out_size, ws_size, (size_t)WS_END); grid_blocks = -1; return; }
        int dev = 0, cus = 0, per_cu = 0;
        hipGetDevice(&dev);
        hipDeviceGetAttribute(&cus, hipDeviceAttributeMultiprocessorCount, dev);
        hipFuncSetAttribute((const void*)fwd_megakernel, hipFuncAttributeMaxDynamicSharedMemorySize, LDS_BYTES);
        hipOccupancyMaxActiveBlocksPerMultiprocessor(&per_cu, (const void*)fwd_megakernel, 512, LDS_BYTES);
        if (per_cu < 1) { fprintf(stderr, "kernel_launch: occupancy query returned %d\n", per_cu); per_cu = 1; }
        grid_blocks = cus * per_cu;
    }
    if (grid_blocks < 0) return;
    Params p{};
    p.x = (const float*)d_in[0]; p.pos = (const int*)d_in[1]; p.attn_norm = (const float*)d_in[2]; p.w_in = (const float*)d_in[3]; p.q_norm = (const float*)d_in[4];
    p.w_uq = (const float*)d_in[5]; p.kv_norm = (const float*)d_in[6]; p.w_ukv = (const float*)d_in[7]; p.gv_norm = (const float*)d_in[8]; p.w_s = (const float*)d_in[9];
    p.b_s = (const float*)d_in[10]; p.mix_norm = (const float*)d_in[11]; p.w_out = (const float*)d_in[12]; p.ffn_norm = (const float*)d_in[13]; p.w_gate = (const float*)d_in[14];
    p.w_up = (const float*)d_in[15]; p.w_down = (const float*)d_in[16]; p.final_norm = (const float*)d_in[17]; p.out = (float*)d_out; p.ws = (unsigned char*)d_ws;
    void* args[] = {&p};
    hipError_t e = hipLaunchCooperativeKernel((const void*)fwd_megakernel, dim3(grid_blocks), dim3(512), args, LDS_BYTES, stream);
    if (e != hipSuccess) fprintf(stderr, "cooperative launch failed: %s (grid %d)\n", hipGetErrorString(e), grid_blocks);
}
```

```cpp
#include <hip/hip_runtime.h>
#include <hip/hip_cooperative_groups.h>
#include <cstdint>
#include <cstdio>
namespace cg = cooperative_groups;

#define LAS __attribute__((address_space(3)))
#define DI __device__ __forceinline__
typedef unsigned short bf16_t;
typedef short bf16x8 __attribute__((ext_vector_type(8)));
typedef short s16x4 __attribute__((ext_vector_type(4)));
typedef float f32x4 __attribute__((ext_vector_type(4)));
typedef float f32x16 __attribute__((ext_vector_type(16)));
typedef unsigned u32x4 __attribute__((ext_vector_type(4)));
typedef unsigned u32x2 __attribute__((ext_vector_type(2)));

constexpr int S = 8192, DM = 2048, NL = 4, DIN = 5184, DINP = 5376, DFF = 5632, NQ = 1280, NKV = 768;
constexpr int Z_RQ = 0, Z_RK = 768, Z_RV = 1536, Z_RG = 2304, Z_CQ = 3072, Z_CKV = 3584, Z_GU = 4096, Z_GV = 4608, Z_KPE = 5120;
constexpr float EPS = 1e-6f;
constexpr float QSCALE = 0.07216878364870322f * 1.4426950408889634f;
constexpr float KSCALE_RET = 0.08838834764831845f;

constexpr size_t MiB = 1u << 20;
constexpr size_t WS_SSQ = 0;
constexpr size_t WS_COSR = 1 * MiB, WS_SINR = 3 * MiB, WS_COSM = 5 * MiB, WS_SINM = 6 * MiB;
constexpr size_t WS_W = 8 * MiB, W_LAYER = 98 * MiB;
constexpr size_t WO_IN = 0, WO_UQ = 21 * MiB, WO_K = 21 * MiB + 1280 * 1024, WO_V = WO_K + 768 * 1024, WO_OUT = 23 * MiB + 768 * 1024, WO_GU = WO_OUT + 8 * MiB, WO_DN = WO_GU + 44 * MiB;
static_assert(WO_DN + 22 * MiB <= W_LAYER, "weights layer");
constexpr size_t WS_XRES = WS_W + 4 * W_LAYER;
constexpr size_t WS_XB = WS_XRES + 64 * MiB;
constexpr size_t WS_Z = WS_XB + 32 * MiB;
constexpr size_t WS_MQ = WS_Z + 84 * MiB;
constexpr size_t WS_HID = WS_Z;
constexpr size_t WS_KN = WS_MQ + 20 * MiB;
constexpr size_t WS_VT = WS_KN + 12 * MiB;
constexpr size_t WS_Y = WS_VT + 12 * MiB;
constexpr size_t WS_KVT = WS_Y + 32 * MiB;
constexpr size_t WS_PREVT = WS_KVT + 24 * MiB;
constexpr size_t WS_PATTN = WS_PREVT + 12 * MiB;
constexpr size_t WS_PFFN = WS_PATTN + 1 * MiB;
constexpr size_t WS_PCQ = WS_PFFN + 1 * MiB;
constexpr size_t WS_PCKV = WS_PCQ + 1 * MiB;
constexpr size_t WS_APART = WS_PCKV + 1 * MiB;
constexpr size_t APART_REC = 8 * 34 * 64;
constexpr size_t WS_END = WS_APART + 56 * MiB;
static_assert((size_t)S * DFF * 2 <= 104 * MiB, "hid overlay");
static_assert(432 * APART_REC * 4 <= 56 * MiB, "attention partials");

constexpr int LDS_BYTES = 147456;

struct Params {
    const float* x; const int* pos; const float* attn_norm; const float* w_in; const float* q_norm; const float* w_uq; const float* kv_norm; const float* w_ukv;
    const float* gv_norm; const float* w_s; const float* b_s; const float* mix_norm; const float* w_out; const float* ffn_norm; const float* w_gate; const float* w_up;
    const float* w_down; const float* final_norm; float* out; unsigned char* ws;
};

DI unsigned f2bf(float f) { unsigned u = __builtin_bit_cast(unsigned, f); return (u + 0x7fffu + ((u >> 16) & 1u)) >> 16; }
typedef float f32x2_t __attribute__((ext_vector_type(2))); typedef __bf16 bf16x2_t __attribute__((ext_vector_type(2)));
DI unsigned pk2(float lo, float hi) { const f32x2_t v = {lo, hi}; const bf16x2_t b = __builtin_convertvector(v, bf16x2_t); return __builtin_bit_cast(unsigned, b); }
DI float half_max(float m) { auto rr = __builtin_amdgcn_permlane32_swap(__float_as_uint(m), __float_as_uint(m), false, false); return fmaxf(__uint_as_float(rr[0]), __uint_as_float(rr[1])); }
DI float half_sum(float m) { auto rr = __builtin_amdgcn_permlane32_swap(__float_as_uint(m), __float_as_uint(m), false, false); return __uint_as_float(rr[0]) + __uint_as_float(rr[1]); }
DI float bf2f(unsigned short b) { return __builtin_bit_cast(float, (unsigned)b << 16); }
DI float bflo(unsigned w) { return __builtin_bit_cast(float, w << 16); }
DI float bfhi(unsigned w) { return __builtin_bit_cast(float, w & 0xffff0000u); }
DI float gelu_tanh(float x) { const float u = 0.7978845608028654f * (x + 0.044715f * x * x * x); const float e = __builtin_amdgcn_exp2f(2.885390081777927f * u); const float t = 1.f - 2.f * __builtin_amdgcn_rcpf(e + 1.f); return 0.5f * x * (1.f + t); }
DI float silu(float x) { return x * __builtin_amdgcn_rcpf(1.f + __builtin_amdgcn_exp2f(-1.4426950408889634f * x)); }
DI int tid_opaque() { int t = threadIdx.x; asm volatile("" : "+v"(t)); return t; }
DI int sgpr_opaque(int v) { asm volatile("" : "+s"(v)); return v; }

namespace pg8 {
constexpr int BM = 256, BK = 64, HALF = 128, HTB = HALF * BK * 2, STAGE_BYTES = 8 * HTB, NXCD = 8, WGM = 8;
__host__ __device__ __forceinline__ int lds_byte(int r, int c) { const int st = (r >> 4) * 2 + (c >> 5), rr = r & 15, cc = c & 31, ob = rr * 64 + cc * 2; return st * 1024 + (ob ^ (((ob >> 9) & 1) << 5)); }
__host__ __device__ __forceinline__ void stage_rc(int b, int& R, int& C) { const int st = b / 1024, sb = b % 1024, swz = sb ^ (((sb >> 9) & 1) << 5); R = (st >> 1) * 16 + swz / 64; C = (st & 1) * 32 + (swz % 64) / 2; }
__host__ __device__ __forceinline__ int perm32(int rho) { const int n = rho >> 4, i = rho & 15; return 8 * (i >> 2) + 4 * n + (i & 3); }
struct Unit { int pm, pn; };
struct Gemm { const bf16_t* A; const bf16_t* Bt; int M, N, K, lda, ldb; };
struct StaticOrder {
    int nM, nN, nwg, G, c;
    __device__ void init(int M, int N, int G_, int c_) { nM = M / BM; nN = N / BM; nwg = nM * nN; G = G_; c = c_; }
    __device__ bool next(int i, Unit& u) const {
        const long L = (long)i * G + c; if (L >= nwg) return false;
        int wgid = (int)L; { const int q = nwg / NXCD, r = nwg % NXCD, xcd = wgid % NXCD, off = wgid / NXCD; wgid = (xcd < r ? xcd * (q + 1) : r * (q + 1) + (xcd - r) * q) + off; }
        const int nig = WGM * nN, gid = wgid / nig, fm = gid * WGM, gsz = (nM - fm) < WGM ? (nM - fm) : WGM;
        u.pm = fm + ((wgid % nig) % gsz); u.pn = (wgid % nig) / gsz; return true;
    }
};

template <class Epi>
__device__ __forceinline__ void gemm_phase(LAS unsigned char* lds, const Gemm g, const StaticOrder& S, const Epi& E) {
    const int tid = tid_opaque(), wid = __builtin_amdgcn_readfirstlane(tid >> 6), lane = tid & 63, wr = wid >> 2, wc = wid & 3, fr = lane & 15, fq = lane >> 4;
    const int K = g.K, nt = K / BK;
    unsigned voffA[2], voffB[2];
#pragma unroll
    for (int i = 0; i < 2; ++i) { int R, C; stage_rc(tid * 16 + i * 8192, R, C); const int Rb = Epi::PERM ? ((R & ~31) + perm32(R & 31)) : R;
        voffA[i] = (unsigned)(R * g.lda + C) * 2u; voffB[i] = (unsigned)(Rb * g.ldb + C) * 2u; }
    const size_t kstep = (size_t)(BK * 2);
    const size_t hstepA = (size_t)HALF * g.lda * 2, hstepB = (size_t)HALF * g.ldb * 2;
    const size_t tstepA = 2 * hstepA, tstepB = 2 * hstepB;
    const unsigned ldsw = (unsigned)wid * 1024u;
    const int aoff = lds_byte(wr * 64 + fr, fq * 8), boff = lds_byte(wc * 32 + fr, fq * 8);
#define PG8_SA(b, h) (((b) * 2 + (h)) * HTB)
#define PG8_SB(b, h) ((4 + (b) * 2 + (h)) * HTB)
#define PG8_STAGE(bufoff, gbase, voff) do { _Pragma("unroll") for (int _i = 0; _i < 2; ++_i) \
        __builtin_amdgcn_global_load_lds((const unsigned*)((const char*)(gbase) + (voff)[_i]), (LAS unsigned*)(lds + (bufoff) + ldsw + _i * 8192), 16, 0, 0); } while (0)
#define PG8_LDA(dst, b, h) do { _Pragma("unroll") for (int m = 0; m < 4; ++m) _Pragma("unroll") for (int k = 0; k < 2; ++k) dst[m][k] = *(const LAS bf16x8*)(lds + PG8_SA(b, h) + aoff + m * 2048 + k * 1024); } while (0)
#define PG8_LDB(dst, b, h) do { _Pragma("unroll") for (int n = 0; n < 2; ++n) _Pragma("unroll") for (int k = 0; k < 2; ++k) dst[n][k] = *(const LAS bf16x8*)(lds + PG8_SB(b, h) + boff + n * 2048 + k * 1024); } while (0)
#define PG8_MMA(ai, bj, At, Bt) do { __builtin_amdgcn_s_setprio(1); _Pragma("unroll") for (int m = 0; m < 4; ++m) _Pragma("unroll") for (int n = 0; n < 2; ++n) _Pragma("unroll") for (int k = 0; k < 2; ++k) \
        acc[ai][bj][m][n] = __builtin_amdgcn_mfma_f32_16x16x32_bf16(Bt[n][k], At[m][k], acc[ai][bj][m][n], 0, 0, 0); __builtin_amdgcn_s_setprio(0); } while (0)
#define PG8_WAIT_V(n) asm volatile("s_waitcnt vmcnt(" #n ")" ::: "memory")
#define PG8_WAIT_L(n) asm volatile("s_waitcnt lgkmcnt(" #n ")" ::: "memory")
#define PG8_BAR __builtin_amdgcn_s_barrier()
#define PG8_SCHED __builtin_amdgcn_sched_barrier(0)
    Unit cur, nxt; int ui = 0;
    if (!S.next(0, cur)) return;
    f32x4 acc[2][2][4][2];
#pragma unroll
    for (int a = 0; a < 2; ++a)
#pragma unroll
        for (int b = 0; b < 2; ++b)
#pragma unroll
            for (int m = 0; m < 4; ++m)
#pragma unroll
                for (int n = 0; n < 2; ++n) acc[a][b][m][n] = (f32x4){0.f, 0.f, 0.f, 0.f};
    bf16x8 At[4][2], B0[2][2], B1[2][2];
    const char* cA = (const char*)g.A + (size_t)cur.pm * tstepA; const char* cB = (const char*)g.Bt + (size_t)cur.pn * tstepB;
    PG8_STAGE(PG8_SB(0, 0), cB, voffB); PG8_STAGE(PG8_SB(0, 1), cB + hstepB, voffB); PG8_STAGE(PG8_SA(0, 0), cA, voffA); PG8_STAGE(PG8_SA(0, 1), cA + hstepA, voffA);
    if (wr == 1) PG8_BAR;
    PG8_WAIT_V(2); PG8_BAR;
    PG8_STAGE(PG8_SB(1, 0), cB + kstep, voffB); PG8_STAGE(PG8_SA(1, 0), cA + kstep, voffA); PG8_STAGE(PG8_SB(1, 1), cB + hstepB + kstep, voffB);
    PG8_WAIT_V(6); PG8_BAR;
    for (;;) {
        const bool has_next = S.next(ui + 1, nxt);
        const char* nA = has_next ? (const char*)g.A + (size_t)nxt.pm * tstepA : cA; const char* nB = has_next ? (const char*)g.Bt + (size_t)nxt.pn * tstepB : cB;
        for (int t = 0; t < nt; t += 2) {
            const bool last = (t == nt - 2);
            const char* a1 = cA + (size_t)(t + 1) * kstep;
            const char* a2 = last ? nA : cA + (size_t)(t + 2) * kstep; const char* b2 = last ? nB : cB + (size_t)(t + 2) * kstep;
            const char* a3 = a2 + kstep; const char* b3 = b2 + kstep;
            PG8_LDB(B0, 0, 0); PG8_LDB(B1, 0, 1); PG8_SCHED; PG8_LDA(At, 0, 0); PG8_STAGE(PG8_SA(1, 1), a1 + hstepA, voffA);
            PG8_WAIT_V(8); PG8_WAIT_L(0); PG8_BAR; PG8_MMA(0, 0, At, B0); PG8_MMA(0, 1, At, B1); PG8_BAR; PG8_SCHED;
            PG8_LDA(At, 0, 1); PG8_STAGE(PG8_SB(0, 0), b2, voffB); PG8_STAGE(PG8_SB(0, 1), b2 + hstepB, voffB); PG8_STAGE(PG8_SA(0, 0), a2, voffA);
            PG8_WAIT_V(8); PG8_WAIT_L(0); PG8_BAR; PG8_MMA(1, 0, At, B0); PG8_MMA(1, 1, At, B1); PG8_BAR; PG8_SCHED;
            PG8_LDB(B0, 1, 0); PG8_LDB(B1, 1, 1); PG8_SCHED; PG8_LDA(At, 1, 0); PG8_STAGE(PG8_SA(0, 1), a2 + hstepA, voffA);
            PG8_WAIT_V(8); PG8_WAIT_L(0); PG8_BAR; PG8_MMA(0, 0, At, B0); PG8_MMA(0, 1, At, B1); PG8_BAR; PG8_SCHED;
            PG8_LDA(At, 1, 1); PG8_STAGE(PG8_SB(1, 0), b3, voffB); PG8_STAGE(PG8_SB(1, 1), b3 + hstepB, voffB); PG8_STAGE(PG8_SA(1, 0), a3, voffA);
            PG8_WAIT_V(8); PG8_WAIT_L(0); PG8_BAR; PG8_MMA(1, 0, At, B0); PG8_MMA(1, 1, At, B1); PG8_BAR; PG8_SCHED;
        }
        if (wr == 0) PG8_BAR;
        E(acc, cur, wr, wc, fr, fq);
        PG8_WAIT_V(0);
        if (!has_next) break;
#pragma unroll
        for (int a = 0; a < 2; ++a)
#pragma unroll
            for (int b = 0; b < 2; ++b)
#pragma unroll
                for (int m = 0; m < 4; ++m)
#pragma unroll
                    for (int n = 0; n < 2; ++n) acc[a][b][m][n] = (f32x4){0.f, 0.f, 0.f, 0.f};
        cur = nxt; cA = nA; cB = nB; ++ui;
        if (wr == 1) PG8_BAR;
    }
    PG8_WAIT_V(0);
    PG8_BAR;
#undef PG8_SA
#undef PG8_SB
#undef PG8_STAGE
#undef PG8_LDA
#undef PG8_LDB
#undef PG8_MMA
#undef PG8_WAIT_V
#undef PG8_WAIT_L
#undef PG8_BAR
#undef PG8_SCHED
}
}

typedef f32x4 Acc[2][2][4][2];
DI u32x4 pack8(const float* v) { u32x4 w; w.x = pk2(v[0], v[1]); w.y = pk2(v[2], v[3]); w.z = pk2(v[4], v[5]); w.w = pk2(v[6], v[7]); return w; }
DI float quad_sum(float s) { s += __shfl_xor(s, 16); s += __shfl_xor(s, 32); return s; }

DI float rowsum32(const float* part, int row, int fq) {
    const f32x4 a = *(const f32x4*)(part + (size_t)row * 32 + 8 * fq), b = *(const f32x4*)(part + (size_t)row * 32 + 8 * fq + 4);
    return quad_sum(((a[0] + a[1]) + (a[2] + a[3])) + ((b[0] + b[1]) + (b[2] + b[3])));
}
DI float rowsum8(const float* part, int row, int fq) {
    const float a = part[(size_t)row * 8 + 2 * fq], b = part[(size_t)row * 8 + 2 * fq + 1];
    return quad_sum(a + b);
}
DI float rowsum8_full(const float* part, int row) {
    const f32x4 a = *(const f32x4*)(part + (size_t)row * 8), b = *(const f32x4*)(part + (size_t)row * 8 + 4);
    return ((a[0] + a[1]) + (a[2] + a[3])) + ((b[0] + b[1]) + (b[2] + b[3]));
}
struct EpiIn {
    static constexpr bool PERM = true;
    bf16_t* z; const float* ssq_in; float* ssq_cq; float* ssq_ckv; const float* cosr; const float* sinr; const float* cosm; const float* sinm;
    DI void operator()(const Acc& acc, const pg8::Unit& u, int wr, int wc, int fr, int fq) const {
        const int pn = u.pn;
        const int mode = pn < 3 ? 0 : pn < 6 ? 1 : pn < 12 ? 2 : pn < 14 ? 3 : pn < 16 ? 4 : pn < 20 ? 5 : 6;
#pragma unroll
        for (int ai = 0; ai < 2; ++ai)
#pragma unroll
            for (int m = 0; m < 4; ++m) {
                const int row = u.pm * 256 + ai * 128 + wr * 64 + m * 16 + fr;
                const float rs = rsqrtf(rowsum32(ssq_in, row, fq) * (1.f / DM) + EPS);
                float ss = 0.f;
#pragma unroll
                for (int bj = 0; bj < 2; ++bj) {
                    const int c0 = pn * 256 + bj * 128 + wc * 32 + 8 * fq;
                    float v[8];
#pragma unroll
                    for (int i = 0; i < 4; ++i) { v[i] = acc[ai][bj][m][0][i] * rs; v[4 + i] = acc[ai][bj][m][1][i] * rs; }
                    if (mode <= 1) {
                        const int d0 = ((c0 & 127) >> 3) * 4;
                        const f32x4 cs = *(const f32x4*)(cosr + (size_t)row * 64 + d0), sn = *(const f32x4*)(sinr + (size_t)row * 64 + d0);
                        const float sc = mode == 1 ? KSCALE_RET : 1.f;
#pragma unroll
                        for (int i = 0; i < 4; ++i) { const float x1 = v[i], x2 = v[4 + i]; v[i] = (x1 * cs[i] - x2 * sn[i]) * sc; v[4 + i] = (x2 * cs[i] + x1 * sn[i]) * sc; }
                    } else if (mode == 3 || mode == 4) {
#pragma unroll
                        for (int i = 0; i < 8; ++i) ss += v[i] * v[i];
                    } else if (mode == 5) {
#pragma unroll
                        for (int i = 0; i < 8; ++i) v[i] = gelu_tanh(v[i]);
                    } else if (mode == 6) {
                        if (c0 < Z_KPE + 64) {
                            const int d0 = ((c0 - Z_KPE) >> 3) * 4;
                            const f32x4 cs = *(const f32x4*)(cosm + (size_t)row * 32 + d0), sn = *(const f32x4*)(sinm + (size_t)row * 32 + d0);
#pragma unroll
                            for (int i = 0; i < 4; ++i) { const float x1 = v[i], x2 = v[4 + i]; v[i] = x1 * cs[i] - x2 * sn[i]; v[4 + i] = x2 * cs[i] + x1 * sn[i]; }
                        }
                    }
                    *(u32x4*)(z + (size_t)row * DINP + c0) = pack8(v);
                }
                if (mode == 3 || mode == 4) { ss = quad_sum(ss); if (fq == 0) (mode == 3 ? ssq_cq : ssq_ckv)[(size_t)row * 8 + (pn & 1) * 4 + wc] = ss; }
            }
    }
};
struct EpiQ {
    static constexpr bool PERM = true;
    bf16_t* mq; const float* ssq; const float* cosm; const float* sinm;
    DI void operator()(const Acc& acc, const pg8::Unit& u, int wr, int wc, int fr, int fq) const {
#pragma unroll
        for (int ai = 0; ai < 2; ++ai)
#pragma unroll
            for (int m = 0; m < 4; ++m) {
                const int row = u.pm * 256 + ai * 128 + wr * 64 + m * 16 + fr;
                const float rs = rsqrtf(rowsum8(ssq, row, fq) * (1.f / 512.f) + EPS) * QSCALE;
#pragma unroll
                for (int bj = 0; bj < 2; ++bj) {
                    const int c0 = u.pn * 256 + bj * 128 + wc * 32 + 8 * fq;
                    float v[8];
#pragma unroll
                    for (int i = 0; i < 4; ++i) { v[i] = acc[ai][bj][m][0][i] * rs; v[4 + i] = acc[ai][bj][m][1][i] * rs; }
                    if (c0 >= 768 && c0 < 1152) {
                        const int d0 = (((c0 - 768) & 63) >> 3) * 4;
                        const f32x4 cs = *(const f32x4*)(cosm + (size_t)row * 32 + d0), sn = *(const f32x4*)(sinm + (size_t)row * 32 + d0);
#pragma unroll
                        for (int i = 0; i < 4; ++i) { const float x1 = v[i], x2 = v[4 + i]; v[i] = x1 * cs[i] - x2 * sn[i]; v[4 + i] = x2 * cs[i] + x1 * sn[i]; }
                    }
                    *(u32x4*)(mq + (size_t)row * NQ + c0) = pack8(v);
                }
            }
    }
};
struct EpiRowScale {
    static constexpr bool PERM = true;
    bf16_t* o; int ldo; const float* ssq; float inv_n;
    DI void operator()(const Acc& acc, const pg8::Unit& u, int wr, int wc, int fr, int fq) const {
#pragma unroll
        for (int ai = 0; ai < 2; ++ai)
#pragma unroll
            for (int m = 0; m < 4; ++m) {
                const int row = u.pm * 256 + ai * 128 + wr * 64 + m * 16 + fr;
                const float rs = rsqrtf(rowsum8(ssq, row, fq) * inv_n + EPS);
#pragma unroll
                for (int bj = 0; bj < 2; ++bj) {
                    const int c0 = u.pn * 256 + bj * 128 + wc * 32 + 8 * fq;
                    float v[8];
#pragma unroll
                    for (int i = 0; i < 4; ++i) { v[i] = acc[ai][bj][m][0][i] * rs; v[4 + i] = acc[ai][bj][m][1][i] * rs; }
                    *(u32x4*)(o + (size_t)row * ldo + c0) = pack8(v);
                }
            }
    }
};
struct EpiColScale {
    static constexpr bool PERM = true;
    bf16_t* o; int ldo; const float* ssq; float inv_n;
    DI void operator()(const Acc& acc, const pg8::Unit& u, int wr, int wc, int fr, int fq) const {
#pragma unroll
        for (int bj = 0; bj < 2; ++bj) {
            const int c0 = u.pn * 256 + bj * 128 + wc * 32 + 8 * fq;
            float rs[8];
#pragma unroll
            for (int i = 0; i < 8; ++i) rs[i] = rsqrtf(rowsum8_full(ssq, c0 + i) * inv_n + EPS);
#pragma unroll
            for (int ai = 0; ai < 2; ++ai)
#pragma unroll
                for (int m = 0; m < 4; ++m) {
                    const int row = u.pm * 256 + ai * 128 + wr * 64 + m * 16 + fr;
                    float v[8];
#pragma unroll
                    for (int i = 0; i < 4; ++i) { v[i] = acc[ai][bj][m][0][i] * rs[i]; v[4 + i] = acc[ai][bj][m][1][i] * rs[4 + i]; }
                    *(u32x4*)(o + (size_t)row * ldo + c0) = pack8(v);
                }
        }
    }
};
struct EpiResid {
    static constexpr bool PERM = true;
    bf16_t* xb; float* ssq_out;
    DI void operator()(const Acc& acc, const pg8::Unit& u, int wr, int wc, int fr, int fq) const {
#pragma unroll
        for (int ai = 0; ai < 2; ++ai)
#pragma unroll
            for (int m = 0; m < 4; ++m) {
                const int row = u.pm * 256 + ai * 128 + wr * 64 + m * 16 + fr;
                float ss = 0.f;
#pragma unroll
                for (int bj = 0; bj < 2; ++bj) {
                    const size_t off = (size_t)row * DM + u.pn * 256 + bj * 128 + wc * 32 + 8 * fq;
                    const u32x4 rw = *(const u32x4*)(xb + off);
                    float o[8];
                    o[0] = bflo(rw.x) + acc[ai][bj][m][0][0]; o[1] = bfhi(rw.x) + acc[ai][bj][m][0][1]; o[2] = bflo(rw.y) + acc[ai][bj][m][0][2]; o[3] = bfhi(rw.y) + acc[ai][bj][m][0][3];
                    o[4] = bflo(rw.z) + acc[ai][bj][m][1][0]; o[5] = bfhi(rw.z) + acc[ai][bj][m][1][1]; o[6] = bflo(rw.w) + acc[ai][bj][m][1][2]; o[7] = bfhi(rw.w) + acc[ai][bj][m][1][3];
                    *(u32x4*)(xb + off) = pack8(o);
#pragma unroll
                    for (int i = 0; i < 8; ++i) ss += o[i] * o[i];
                }
                ss = quad_sum(ss);
                if (fq == 0) ssq_out[(size_t)row * 32 + u.pn * 4 + wc] = ss;
            }
    }
};
struct EpiGLU {
    static constexpr bool PERM = true;
    bf16_t* hid; const float* ssq;
    DI void operator()(const Acc& acc, const pg8::Unit& u, int wr, int wc, int fr, int fq) const {
#pragma unroll
        for (int ai = 0; ai < 2; ++ai)
#pragma unroll
            for (int m = 0; m < 4; ++m) {
                const int row = u.pm * 256 + ai * 128 + wr * 64 + m * 16 + fr;
                const float rs = rsqrtf(rowsum32(ssq, row, fq) * (1.f / DM) + EPS);
                float v[8];
#pragma unroll
                for (int i = 0; i < 4; ++i) {
                    v[i] = silu(acc[ai][0][m][0][i] * rs) * (acc[ai][1][m][0][i] * rs);
                    v[4 + i] = silu(acc[ai][0][m][1][i] * rs) * (acc[ai][1][m][1][i] * rs);
                }
                *(u32x4*)(hid + (size_t)row * DFF + u.pn * 128 + wc * 32 + 8 * fq) = pack8(v);
            }
    }
};

struct ColMapIn { const float* w; DI const float* operator()(int n) const {
    if (n < 1536) { const int p = n & 127, a = p >> 3, i = p & 7; return w + (n - p) + 4 * a + (i & 3) + 64 * (i >> 2); }
    if (n < 4096) return w + n;
    if (n < 5120) return w + n + 64;
    if (n < 5184) { const int p = n - 5120, a = p >> 3, i = p & 7; return w + 4096 + 4 * a + (i & 3) + 32 * (i >> 2); }
    return nullptr; } };
struct ColMapUq { const float* w; DI const float* operator()(int n) const {
    if (n < 768) return w + (n >> 7) * 192 + (n & 127);
    if (n < 1152) { const int q = n - 768, hh = q >> 6, p = q & 63, a = p >> 3, i = p & 7; return w + hh * 192 + 128 + 4 * a + (i & 3) + 32 * (i >> 2); }
    return nullptr; } };
struct ColMapKv { const float* w; int off; DI const float* operator()(int n) const { return w + (n >> 7) * 256 + off + (n & 127); } };
struct ColMapId { const float* w; DI const float* operator()(int n) const { return w + n; } };
struct ColMapGu { const float* wg; const float* wu; DI const float* operator()(int n) const { const int t = n >> 8, r = n & 255; return r < 128 ? wg + t * 128 + r : wu + t * 128 + (r - 128); } };

template <class CM>
DI void convert_T(LAS float* tile, bf16_t* dst, int K, int Nd, int srcN, const float* gain, const CM cm, int bid, int nb, int& off) {
    const int tid = tid_opaque(), n4 = tid & 31, kk = tid >> 5;
    const int nkt = K / 64, nnt = Nd / 128, nitems = nkt * nnt;
    int it = bid - off; if (it < 0) it += nb;
    off = (off + nitems) % nb;
    constexpr int NF = 4;
    f32x4 v[NF][4];
#define CVT_LOAD(f, item_) do { const int k0_ = ((item_) / nnt) * 64, n0_ = ((item_) % nnt) * 128; const float* src_ = cm(n0_ + 4 * n4); \
        _Pragma("unroll") for (int p = 0; p < 4; ++p) { const int k_ = k0_ + kk + 16 * p; \
            if (src_) { v[f][p] = *(const f32x4*)(src_ + (size_t)k_ * srcN); if (gain) { const float g_ = gain[k_]; v[f][p] = v[f][p] * g_; } } else v[f][p] = (f32x4){0.f, 0.f, 0.f, 0.f}; } } while (0)
#define CVT_STORE(f, item_) do { const int k0_ = ((item_) / nnt) * 64, n0_ = ((item_) % nnt) * 128; \
        _Pragma("unroll") for (int p = 0; p < 4; ++p) { const int k_ = kk + 16 * p; *(LAS f32x4*)(tile + k_ * 128 + ((4 * n4) ^ (8 * ((k_ >> 3) & 3)))) = v[f][p]; } \
        __syncthreads(); \
        if ((item_) + NF * nb < nitems) CVT_LOAD(f, (item_) + NF * nb); \
        _Pragma("unroll") for (int q = 0; q < 2; ++q) { const int c = tid & 7, n = (tid >> 3) + 64 * q, nsw = n ^ (8 * (c & 3)); float o[8];     \
            _Pragma("unroll") for (int j = 0; j < 8; ++j) o[j] = tile[(8 * c + j) * 128 + nsw]; \
            *(u32x4*)(dst + (size_t)(n0_ + n) * K + k0_ + 8 * c) = pack8(o); } \
        __syncthreads(); } while (0)
#pragma unroll
    for (int f = 0; f < NF; ++f) if (it + f * nb < nitems) CVT_LOAD(f, it + f * nb);
    for (; it < nitems; it += NF * nb) {
#pragma unroll
        for (int f = 0; f < NF; ++f) if (it + f * nb < nitems) CVT_STORE(f, it + f * nb);
    }
#undef CVT_LOAD
#undef CVT_STORE
}

constexpr int T136 = 136, TILE_B = 128 * T136 * 2;
DI void mm128(const LAS unsigned char* A, const LAS unsigned char* Bt, f32x4 (&acc)[8], int w, int fr, int fq) {
#pragma unroll
    for (int ks = 0; ks < 4; ++ks) {
        const bf16x8 a = *(const LAS bf16x8*)(A + ((16 * w + fr) * T136 + 32 * ks + 8 * fq) * 2);
#pragma unroll
        for (int nb = 0; nb < 8; ++nb) {
            const bf16x8 b = *(const LAS bf16x8*)(Bt + ((16 * nb + fr) * T136 + 32 * ks + 8 * fq) * 2);
            acc[nb] = __builtin_amdgcn_mfma_f32_16x16x32_bf16(b, a, acc[nb], 0, 0, 0);
        }
    }
}
DI void stage_rows(int tid, LAS unsigned char* T, const bf16_t* g, size_t ld) {
#pragma unroll
    for (int p = 0; p < 4; ++p) { const int q = tid + 512 * p, r = q >> 4, c = q & 15; *(LAS u32x4*)(T + (r * T136 + 8 * c) * 2) = *(const u32x4*)(g + (size_t)r * ld + 8 * c); }
}
DI void tile_load(int tid, u32x4 (&v)[4], const bf16_t* g, size_t ld) {
    const int r = tid & 127;
#pragma unroll
    for (int p = 0; p < 4; ++p) v[p] = *(const u32x4*)(g + (size_t)r * ld + 8 * ((tid >> 7) + 4 * p));
}
DI void tile_store_T(int tid, LAS unsigned char* T, const u32x4 (&v)[4], const LAS float* rowscale, const float* colgain) {
    const int r = tid & 127;
    const float rs = rowscale ? rowscale[r] : 1.f;
#pragma unroll
    for (int p = 0; p < 4; ++p) {
        const int cc = (tid >> 7) + 4 * p;
        const unsigned w[4] = {v[p].x, v[p].y, v[p].z, v[p].w};
#pragma unroll
        for (int j = 0; j < 4; ++j) {
            const int c0 = 8 * cc + 2 * j;
            float a = bflo(w[j]) * rs, b = bfhi(w[j]) * rs;
            if (colgain) { a *= colgain[c0]; b *= colgain[c0 + 1]; }
            *(LAS unsigned short*)(T + ((c0) * T136 + r) * 2) = (unsigned short)f2bf(a);
            *(LAS unsigned short*)(T + ((c0 + 1) * T136 + r) * 2) = (unsigned short)f2bf(b);
        }
    }
}

DI float ret_log_gamma(int h) {
    return h == 0 ? -3.1748698315e-02f : h == 1 ? -1.5748356968e-02f : h == 2 ? -7.8431774610e-03f : h == 3 ? -3.9138993211e-03f : h == 4 ? -1.9550348358e-03f : -9.7703964783e-04f; }

DI void ret_kv_unit(LAS unsigned char* lds, int n, int h, const bf16_t* z, float* kvT) {
    const int tid = tid_opaque(), w = tid >> 6, lane = tid & 63, fr = lane & 15, fq = lane >> 4;
    LAS unsigned char* TA = lds; LAS unsigned char* TB = lds + TILE_B; LAS float* dec = (LAS float*)(lds + 2 * TILE_B);
    const float lg = ret_log_gamma(h);
    const bf16_t* zr = z + (size_t)n * 128 * DINP;
    u32x4 vv[4], kk[4];
    tile_load(tid, vv, zr + Z_RV + h * 128, DINP); tile_load(tid, kk, zr + Z_RK + h * 128, DINP);
    __syncthreads();
    if (tid < 128) dec[tid] = __expf(lg * (127.f - (float)tid));
    __syncthreads();
    tile_store_T(tid, TA, vv, nullptr, nullptr);
    tile_store_T(tid, TB, kk, dec, nullptr);
    __syncthreads();
    f32x4 acc[8];
#pragma unroll
    for (int i = 0; i < 8; ++i) acc[i] = (f32x4){0.f, 0.f, 0.f, 0.f};
    mm128(TA, TB, acc, w, fr, fq);
    float* o = kvT + ((size_t)(n * 6 + h) * 128 + 16 * w + fr) * 128 + 4 * fq;
#pragma unroll
    for (int nb = 0; nb < 8; ++nb) *(f32x4*)(o + 16 * nb) = acc[nb];
}

DI void ret_out_unit(LAS unsigned char* lds, int n, int h, const bf16_t* z, const bf16_t* prevT, const float* mixg, bf16_t* y) {
    const int tid = tid_opaque(), w = tid >> 6, lane = tid & 63, fr = lane & 15, fq = lane >> 4;
    LAS unsigned char* TQ = lds; LAS unsigned char* TK = lds + TILE_B; LAS unsigned char* TS = lds + 2 * TILE_B; LAS unsigned char* TP = lds + 3 * TILE_B;
    const float lg = ret_log_gamma(h);
    const bf16_t* zr = z + (size_t)n * 128 * DINP;
    u32x4 vv[4];
    tile_load(tid, vv, zr + Z_RV + h * 128, DINP);
    __syncthreads();
    stage_rows(tid, TQ, zr + Z_RQ + h * 128, DINP);
    stage_rows(tid, TK, zr + Z_RK + h * 128, DINP);
    stage_rows(tid, TP, prevT + (size_t)(n * 6 + h) * 16384, 128);
    __syncthreads();
    f32x4 acc[8];
#pragma unroll
    for (int i = 0; i < 8; ++i) acc[i] = (f32x4){0.f, 0.f, 0.f, 0.f};
    mm128(TQ, TK, acc, w, fr, fq);
    const int irow = 16 * w + fr;
#pragma unroll
    for (int nb = 0; nb < 8; ++nb) {
        float v[4];
#pragma unroll
        for (int i = 0; i < 4; ++i) { const int j = 16 * nb + 4 * fq + i; const int rel = irow - j; v[i] = rel >= 0 ? acc[nb][i] * __expf(lg * (float)rel) : 0.f; }
        u32x2 wv; wv.x = pk2(v[0], v[1]); wv.y = pk2(v[2], v[3]);
        *(LAS u32x2*)(TS + (irow * T136 + 16 * nb + 4 * fq) * 2) = wv;
    }
    __syncthreads();
    tile_store_T(tid, TK, vv, nullptr, nullptr);
    __syncthreads();
    f32x4 a1[8], a2[8];
#pragma unroll
    for (int i = 0; i < 8; ++i) { a1[i] = (f32x4){0.f, 0.f, 0.f, 0.f}; a2[i] = (f32x4){0.f, 0.f, 0.f, 0.f}; }
    mm128(TS, TK, a1, w, fr, fq);
    mm128(TQ, TP, a2, w, fr, fq);
    const float qd = __expf(lg * (float)(irow + 1));
    float ss = 0.f;
#pragma unroll
    for (int nb = 0; nb < 8; ++nb)
#pragma unroll
        for (int i = 0; i < 4; ++i) { const float o = a1[nb][i] + qd * a2[nb][i]; a1[nb][i] = o; ss += o * o; }
    ss = quad_sum(ss);
    const float rs = rsqrtf(ss * (1.f / 128.f) + EPS);
    const size_t tok = (size_t)n * 128 + irow;
#pragma unroll
    for (int nb = 0; nb < 8; ++nb) {
        const int e0 = 16 * nb + 4 * fq;
        const u32x2 gw = *(const u32x2*)(z + tok * DINP + Z_RG + h * 128 + e0);
        const f32x4 mg = *(const f32x4*)(mixg + h * 128 + e0);
        const float g0 = silu(bflo(gw.x)), g1 = silu(bfhi(gw.x)), g2 = silu(bflo(gw.y)), g3 = silu(bfhi(gw.y));
        u32x2 o; o.x = pk2(a1[nb][0] * rs * mg[0] * g0, a1[nb][1] * rs * mg[1] * g1); o.y = pk2(a1[nb][2] * rs * mg[2] * g2, a1[nb][3] * rs * mg[3] * g3);
        *(u32x2*)(y + tok * DM + h * 128 + e0) = o;
    }
}

DI void gmlp_unit(LAS unsigned char* lds, int n, int g, const bf16_t* z, const float* w_s, const float* b_s, const float* vgain, const float* mixg, bf16_t* y) {
    const int tid = tid_opaque(), w = tid >> 6, lane = tid & 63, fr = lane & 15, fq = lane >> 4;
    LAS unsigned char* TA = lds; LAS unsigned char* TB = lds + TILE_B; LAS float* part = (LAS float*)(lds + 2 * TILE_B); LAS float* rstd = part + 512;
    const bf16_t* zr = z + (size_t)n * 128 * DINP;
    __syncthreads();
    u32x4 vv[4];
    tile_load(tid, vv, zr + Z_GV + g * 128, DINP);
    {
        const int r = tid & 127; float ss = 0.f;
#pragma unroll
        for (int p = 0; p < 4; ++p) { const unsigned wv[4] = {vv[p].x, vv[p].y, vv[p].z, vv[p].w};
#pragma unroll
            for (int j = 0; j < 4; ++j) { const float a = bflo(wv[j]), b = bfhi(wv[j]); ss += a * a + b * b; } }
        part[(tid >> 7) * 128 + r] = ss;
    }
    __syncthreads();
    if (tid < 128) rstd[tid] = rsqrtf((part[tid] + part[128 + tid] + part[256 + tid] + part[384 + tid]) * (1.f / 128.f) + EPS);
    {
        const float* ws = w_s + (size_t)g * 16384;
#pragma unroll
        for (int p = 0; p < 8; ++p) { const int q = tid + 512 * p, t = q >> 5, s0 = (q & 31) * 4; const f32x4 v = *(const f32x4*)(ws + t * 128 + s0);
            u32x2 o; o.x = pk2(s0 <= t ? v[0] : 0.f, s0 + 1 <= t ? v[1] : 0.f); o.y = pk2(s0 + 2 <= t ? v[2] : 0.f, s0 + 3 <= t ? v[3] : 0.f);
            *(LAS u32x2*)(TA + (t * T136 + s0) * 2) = o; }
    }
    __syncthreads();
    tile_store_T(tid, TB, vv, rstd, vgain + g * 128);
    __syncthreads();
    f32x4 acc[8];
#pragma unroll
    for (int i = 0; i < 8; ++i) acc[i] = (f32x4){0.f, 0.f, 0.f, 0.f};
    mm128(TA, TB, acc, w, fr, fq);
    const int t = 16 * w + fr; const size_t tok = (size_t)n * 128 + t;
    const float bias = b_s[g * 128 + t];
    float ss = 0.f;
#pragma unroll
    for (int nb = 0; nb < 8; ++nb) {
        const u32x2 uw = *(const u32x2*)(z + tok * DINP + Z_GU + g * 128 + 16 * nb + 4 * fq);
        const float u0 = bflo(uw.x), u1 = bfhi(uw.x), u2 = bflo(uw.y), u3 = bfhi(uw.y);
        acc[nb][0] = u0 * (acc[nb][0] + bias); acc[nb][1] = u1 * (acc[nb][1] + bias); acc[nb][2] = u2 * (acc[nb][2] + bias); acc[nb][3] = u3 * (acc[nb][3] + bias);
        ss += (acc[nb][0] * acc[nb][0] + acc[nb][1] * acc[nb][1]) + (acc[nb][2] * acc[nb][2] + acc[nb][3] * acc[nb][3]);
    }
    ss = quad_sum(ss);
    const float rs = rsqrtf(ss * (1.f / 128.f) + EPS);
#pragma unroll
    for (int nb = 0; nb < 8; ++nb) {
        const int c0 = 1536 + g * 128 + 16 * nb + 4 * fq;
        const f32x4 mg = *(const f32x4*)(mixg + c0);
        u32x2 o; o.x = pk2(acc[nb][0] * rs * mg[0], acc[nb][1] * rs * mg[1]); o.y = pk2(acc[nb][2] * rs * mg[2], acc[nb][3] * rs * mg[3]);
        *(u32x2*)(y + tok * DM + c0) = o;
    }
}

constexpr int KSTR = 400, VSTR = 136, ABUF = 45056, AV_OFF = 25600;
__device__ const unsigned ATT_UNITS[80] = {0x8a4001fu, 0x8c8041fu, 0x8ec081fu, 0x9100c1fu, 0x4c40017u, 0x4e80417u, 0x50c0817u, 0x1e4000fu, 0x208040fu, 0x40007u, 0x823e01eu, 0x847c3feu, 0x86ba7deu, 0x88f8bbeu, 0x463e016u, 0x487c3f6u, 0x7a3c01du, 0x7c783ddu, 0x7eb479du, 0x80f0b5du, 0x4ab87d6u, 0x403c015u, 0x1a3c00eu, 0x1c783ceu, 0x723a01cu, 0x74743bcu, 0x76ae75cu, 0x78e8afcu, 0x42763d5u, 0x44b0775u, 0x6a3801bu, 0x6c7039bu, 0x6ea871bu, 0x70e0a9bu, 0x3a38014u, 0x3c70394u, 0x3ea8714u, 0x163800du, 0x187038du, 0x38006u, 0x623601au, 0x646c37au, 0x66a26dau, 0x68d8a3au, 0x3436013u, 0x366c373u, 0x5a34019u, 0x5c68359u, 0x5e9c699u, 0x60d09d9u, 0x38a06d3u, 0x2e34012u, 0x123400cu, 0x146834cu, 0x5232018u, 0x5464338u, 0x5696658u, 0x58c8978u, 0x3066352u, 0x3298672u, 0x2830011u, 0x2a60311u, 0x2c90611u, 0xe3000bu, 0x106030bu, 0x30005u, 0x222e010u, 0x245c2f0u, 0x26885d0u, 0xa2c00au, 0xc582cau, 0x628009u, 0x850289u, 0x28004u, 0x224008u, 0x448248u, 0x20003u, 0x18002u, 0x10001u, 0x8000u};
DI void attn_finish(f32x16 (&o)[4], float l, int h, int qrow, int hi, const float* mixg, bf16_t* y) {
    const float inv = __builtin_amdgcn_rcpf(l);
    float ss = 0.f;
#pragma unroll
    for (int i = 0; i < 4; ++i)
#pragma unroll
        for (int r = 0; r < 16; ++r) { const float v = o[i][r] * inv; o[i][r] = v; ss += v * v; }
    ss = half_sum(ss);
    const float rs = rsqrtf(ss * (1.f / 128.f) + EPS);
    bf16_t* yr = y + (size_t)qrow * DM + 768 + 128 * h;
    const float* mg = mixg + 768 + 128 * h;
#pragma unroll
    for (int db = 0; db < 4; ++db)
#pragma unroll
        for (int gq = 0; gq < 4; ++gq) {
            const int d0 = 32 * db + 8 * gq + 4 * hi;
            const f32x4 gg = *(const f32x4*)(mg + d0);
            u32x2 ov; ov.x = pk2(o[db][4 * gq] * rs * gg[0], o[db][4 * gq + 1] * rs * gg[1]); ov.y = pk2(o[db][4 * gq + 2] * rs * gg[2], o[db][4 * gq + 3] * rs * gg[3]);
            *(u32x2*)(yr + d0) = ov;
        }
}
DI void attn_combine_wave(const float* rec, int k, int h, int qrow0, int lane, const float* mixg, bf16_t* y) {
    const int r32 = lane & 31, hi = lane >> 5;
    float mt = -1e30f;
    for (int i = 0; i < k; ++i) mt = fmaxf(mt, rec[(size_t)i * APART_REC + 32 * 64 + lane]);
    f32x16 o[4];
#pragma unroll
    for (int i = 0; i < 4; ++i)
#pragma unroll
        for (int r = 0; r < 16; ++r) o[i][r] = 0.f;
    float lt = 0.f;
#pragma unroll 1
    for (int i = 0; i < k; ++i) {
        const float* ri = rec + (size_t)i * APART_REC; const unsigned* rw = (const unsigned*)ri;
        const float a = __builtin_amdgcn_exp2f(ri[32 * 64 + lane] - mt);
        lt += ri[33 * 64 + lane] * a;
        unsigned wv[32];
#pragma unroll
        for (int q = 0; q < 32; ++q) wv[q] = rw[q * 64 + lane];
#pragma unroll
        for (int d = 0; d < 4; ++d)
#pragma unroll
            for (int r = 0; r < 16; r += 2) { const unsigned w = wv[d * 8 + (r >> 1)]; o[d][r] += bflo(w) * a; o[d][r + 1] += bfhi(w) * a; }
    }
    attn_finish(o, lt, h, qrow0 + r32, hi, mixg, y);
}
DI void attn_unit(LAS unsigned char* lds, int h, int qb, int s_begin, int s_end, float* part, const bf16_t* mq, const bf16_t* kn, const bf16_t* z, const bf16_t* vt, const float* mixg, bf16_t* y) {
    const int tid = tid_opaque(), w = tid >> 6, lane = tid & 63, r32 = lane & 31, hi = lane >> 5;
    const int q0 = 256 * qb + 32 * w;
    bf16x8 qf[12];
    {
        const bf16_t* qr = mq + (size_t)(q0 + r32) * NQ;
#pragma unroll
        for (int ks = 0; ks < 8; ++ks) qf[ks] = *(const bf16x8*)(qr + 128 * h + 16 * ks + 8 * hi);
#pragma unroll
        for (int ks = 0; ks < 4; ++ks) qf[8 + ks] = *(const bf16x8*)(qr + 768 + 64 * h + 16 * ks + 8 * hi);
    }
    f32x16 o[4];
#pragma unroll
    for (int i = 0; i < 4; ++i)
#pragma unroll
        for (int r = 0; r < 16; ++r) o[i][r] = 0.f;
    float mrow = -1e30f, lrow = 0.f;
    u32x4 kreg[3], vreg[2];
    const bf16_t* knsrc = kn + (size_t)(tid >> 4) * NKV + 128 * h + 8 * (tid & 15);
    const bf16_t* kpsrc = z + (size_t)(tid >> 3) * DINP + Z_KPE + 8 * (tid & 7);
    const bf16_t* vsrc = vt + (size_t)(128 * h + (tid >> 3)) * S + 8 * (tid & 7);
    const int kndst = (tid >> 4) * KSTR + (tid & 15) * 16, kpdst = (tid >> 3) * KSTR + 256 + (tid & 7) * 16;
    const int vdst = AV_OFF + (tid >> 3) * VSTR + (tid & 7) * 16;
#define ATT_LOAD(step_) do { const size_t k0_ = (size_t)64 * (step_); \
        kreg[0] = *(const u32x4*)(knsrc + k0_ * NKV); kreg[1] = *(const u32x4*)(knsrc + (k0_ + 32) * NKV); kreg[2] = *(const u32x4*)(kpsrc + k0_ * DINP); \
        vreg[0] = *(const u32x4*)(vsrc + k0_); vreg[1] = *(const u32x4*)(vsrc + (size_t)64 * S + k0_); } while (0)
#define ATT_STORE(buf_) do { LAS unsigned char* b_ = lds + (buf_) * ABUF; \
        *(LAS u32x4*)(b_ + kndst) = kreg[0]; *(LAS u32x4*)(b_ + kndst + 32 * KSTR) = kreg[1]; *(LAS u32x4*)(b_ + kpdst) = kreg[2]; \
        *(LAS u32x2*)(b_ + vdst) = (u32x2){vreg[0].x, vreg[0].y}; *(LAS u32x2*)(b_ + vdst + 8) = (u32x2){vreg[0].z, vreg[0].w}; \
        *(LAS u32x2*)(b_ + vdst + 64 * VSTR) = (u32x2){vreg[1].x, vreg[1].y}; *(LAS u32x2*)(b_ + vdst + 64 * VSTR + 8) = (u32x2){vreg[1].z, vreg[1].w}; } while (0)
    ATT_LOAD(s_begin);
    ATT_STORE(0);
    if (s_begin + 1 < s_end) ATT_LOAD(s_begin + 1);
    __syncthreads();
    for (int step = s_begin; step < s_end; ++step) {
        const int cur = (step - s_begin) & 1;
        if (step + 1 < s_end) { ATT_STORE(cur ^ 1); if (step + 2 < s_end) ATT_LOAD(step + 2); }
        const int jd = step - 4 * qb;
        if (!(jd >= 0 && 64 * jd > 32 * w + 31)) {
            const LAS unsigned char* kt = lds + cur * ABUF;
            f32x16 p0, p1;
#pragma unroll
            for (int r = 0; r < 16; ++r) { p0[r] = 0.f; p1[r] = 0.f; }
            const LAS unsigned char* kb0 = kt + r32 * KSTR + 16 * hi;
            const LAS unsigned char* vb0 = kt + AV_OFF + r32 * VSTR + 8 * hi;
#define ATT_SCHED __builtin_amdgcn_sched_barrier(0)
#define KLOAD(dst, b_) do { _Pragma("unroll") for (int j = 0; j < 2; ++j) { dst[j][0] = *(const LAS bf16x8*)(kb0 + 32 * (2 * (b_) + j)); dst[j][1] = *(const LAS bf16x8*)(kb0 + 32 * KSTR + 32 * (2 * (b_) + j)); } } while (0)
#define KMMA(src, b_) do { _Pragma("unroll") for (int j = 0; j < 2; ++j) { p0 = __builtin_amdgcn_mfma_f32_32x32x16_bf16(src[j][0], qf[2 * (b_) + j], p0, 0, 0, 0); p1 = __builtin_amdgcn_mfma_f32_32x32x16_bf16(src[j][1], qf[2 * (b_) + j], p1, 0, 0, 0); } } while (0)
#define VLOAD(dst, db_) do { _Pragma("unroll") for (int kb = 0; kb < 2; ++kb) _Pragma("unroll") for (int s = 0; s < 2; ++s) { const LAS unsigned char* vp = vb0 + (db_) * 32 * VSTR + (32 * kb + 16 * s) * 2; \
                const s16x4 lo = *(const LAS s16x4*)vp, hi4 = *(const LAS s16x4*)(vp + 16); dst[2 * kb + s] = __builtin_shufflevector(lo, hi4, 0, 1, 2, 3, 4, 5, 6, 7); } } while (0)
#define VMMA(src, db_) do { _Pragma("unroll") for (int i = 0; i < 4; ++i) o[db_] = __builtin_amdgcn_mfma_f32_32x32x16_bf16(src[i], pf[i], o[db_], 0, 0, 0); } while (0)
            {
                bf16x8 kA[2][2], kB[2][2];
                KLOAD(kA, 0); ATT_SCHED;
                KLOAD(kB, 1); ATT_SCHED; KMMA(kA, 0); ATT_SCHED;
                KLOAD(kA, 2); ATT_SCHED; KMMA(kB, 1); ATT_SCHED;
                KLOAD(kB, 3); ATT_SCHED; KMMA(kA, 2); ATT_SCHED;
                KLOAD(kA, 4); ATT_SCHED; KMMA(kB, 3); ATT_SCHED;
                KLOAD(kB, 5); ATT_SCHED; KMMA(kA, 4); ATT_SCHED;
                KMMA(kB, 5); ATT_SCHED;
            }
            bf16x8 vA[4], vB[4];
            VLOAD(vA, 0); ATT_SCHED;
            if (jd >= 0) {
                const int qrel = 32 * w + r32;
#pragma unroll
                for (int r = 0; r < 16; ++r) { const int kr = 64 * jd + (r & 3) + 8 * (r >> 2) + 4 * hi; if (kr > qrel) p0[r] = -INFINITY; if (kr + 32 > qrel) p1[r] = -INFINITY; }
            }
            float mx = fmaxf(p0[0], p1[0]);
#pragma unroll
            for (int r = 1; r < 16; ++r) mx = fmaxf(mx, fmaxf(p0[r], p1[r]));
            mx = half_max(mx);
            if (__any(mx > mrow + 8.f)) {
                const float mnew = fmaxf(mrow, mx);
                const float alpha = __builtin_amdgcn_exp2f(mrow - mnew);
                lrow *= alpha; mrow = mnew;
#pragma unroll
                for (int i = 0; i < 4; ++i)
#pragma unroll
                    for (int r = 0; r < 16; ++r) o[i][r] *= alpha;
            }
            float ls = 0.f;
#pragma unroll
            for (int r = 0; r < 16; ++r) { p0[r] = __builtin_amdgcn_exp2f(p0[r] - mrow); p1[r] = __builtin_amdgcn_exp2f(p1[r] - mrow); ls += p0[r] + p1[r]; }
            lrow += ls;
            bf16x8 pf[4];
#pragma unroll
            for (int s = 0; s < 2; ++s) {
                u32x4 a, b;
                a.x = pk2(p0[8 * s + 0], p0[8 * s + 1]); a.y = pk2(p0[8 * s + 2], p0[8 * s + 3]); a.z = pk2(p0[8 * s + 4], p0[8 * s + 5]); a.w = pk2(p0[8 * s + 6], p0[8 * s + 7]);
                b.x = pk2(p1[8 * s + 0], p1[8 * s + 1]); b.y = pk2(p1[8 * s + 2], p1[8 * s + 3]); b.z = pk2(p1[8 * s + 4], p1[8 * s + 5]); b.w = pk2(p1[8 * s + 6], p1[8 * s + 7]);
                pf[s] = __builtin_bit_cast(bf16x8, a); pf[2 + s] = __builtin_bit_cast(bf16x8, b);
            }
            ATT_SCHED;
            VLOAD(vB, 1); ATT_SCHED; VMMA(vA, 0); ATT_SCHED;
            VLOAD(vA, 2); ATT_SCHED; VMMA(vB, 1); ATT_SCHED;
            VLOAD(vB, 3); ATT_SCHED; VMMA(vA, 2); ATT_SCHED;
            VMMA(vB, 3); ATT_SCHED;
#undef KLOAD
#undef KMMA
#undef VLOAD
#undef VMMA
#undef ATT_SCHED
        }
        __syncthreads();
    }
#undef ATT_LOAD
#undef ATT_STORE
    lrow = half_sum(lrow);
    if (part) {
        float* rec = part + (size_t)w * 34 * 64; unsigned* rw = (unsigned*)rec;
#pragma unroll
        for (int i = 0; i < 4; ++i)
#pragma unroll
            for (int r = 0; r < 16; r += 2) rw[(i * 8 + (r >> 1)) * 64 + lane] = pk2(o[i][r], o[i][r + 1]);
        rec[32 * 64 + lane] = mrow; rec[33 * 64 + lane] = lrow;
    } else attn_finish(o, lrow, h, q0 + r32, hi, mixg, y);
}

#define XB_TMO      128
#define XB_XCNT(j)  (256  + 64 * (j))
#define XB_XSUB(j)  (1280 + 64 * (j))
#define XB_XGEN(j)  (2304 + 64 * (j))
#define XB_TOP      3328
#define XB_TOPGEN   3392
#define XCD_BAR_WORDS 3456
#define XB_SPIN_CAP (1u << 20)
DI unsigned xb_ld(unsigned* p)              { return __hip_atomic_load(p, __ATOMIC_RELAXED, __HIP_MEMORY_SCOPE_AGENT); }
DI unsigned xb_add(unsigned* p, unsigned v) { return __hip_atomic_fetch_add(p, v, __ATOMIC_RELAXED, __HIP_MEMORY_SCOPE_AGENT); }
DI unsigned xb_xcc_id() { return (unsigned)__builtin_amdgcn_s_getreg((3 << 11) | 20) & 0xFu; }
#define XB_SPIN(cond, bar) do { unsigned _sp = 0; while (cond) { __builtin_amdgcn_s_sleep(1); \
    if ((++_sp & 255u) == 0u) { if (xb_ld(&(bar)[XB_TMO])) break; if (_sp > XB_SPIN_CAP) { atomicAdd(&(bar)[XB_TMO], 1u); break; } } } } while (0)
struct XcdBarrier { unsigned* bar; unsigned x; volatile LAS unsigned* st; };
DI XcdBarrier xcd_barrier_post(unsigned* bar, volatile LAS unsigned* st) {
    XcdBarrier b; b.bar = bar; b.x = xb_xcc_id(); b.st = st;
    if (threadIdx.x == 0) (void)xb_add(&bar[XB_XCNT(b.x)], 1u);
    return b;
}
DI void xcd_barrier_complete(unsigned* bar, unsigned x, unsigned& nloc, unsigned& nx) {
    const unsigned G = gridDim.x * gridDim.y * gridDim.z;
    unsigned sum, cnt, mine, sp = 0u;
    for (;;) {
        sum = 0u; cnt = 0u; mine = 0u;
#pragma unroll
        for (unsigned j = 0; j < 16; ++j) { const unsigned c = xb_ld(&bar[XB_XCNT(j)]); sum += c; cnt += (c > 0u) ? 1u : 0u; mine = (j == x) ? c : mine; }
        if (sum == G) break;
        __builtin_amdgcn_s_sleep(1);
        if ((++sp & 255u) == 0u) { if (xb_ld(&bar[XB_TMO])) break; if (sp > XB_SPIN_CAP) { atomicAdd(&bar[XB_TMO], 1u); break; } }
    }
    nloc = mine > 0u ? mine : 1u; nx = cnt > 0u ? cnt : 1u;
}
DI void xcd_barrier(const XcdBarrier& b) {
    asm volatile("s_waitcnt vmcnt(0)" ::: "memory");
    __syncthreads();
    if (threadIdx.x == 0) {
        unsigned* bar = b.bar;
        __builtin_amdgcn_s_waitcnt(0);
        unsigned nloc = b.st[0], nx = b.st[1];
        if (nloc == 0u) { xcd_barrier_complete(bar, b.x, nloc, nx); b.st[0] = nloc; b.st[1] = nx; }
        const unsigned old = xb_add(&bar[XB_XSUB(b.x)], 1u);
        const unsigned gen = old / nloc;
        if (old + 1u == (gen + 1u) * nloc) {
            __builtin_amdgcn_fence(__ATOMIC_RELEASE, "agent");
            asm volatile("s_waitcnt vmcnt(0)" ::: "memory");
            const unsigned og = xb_add(&bar[XB_TOP], 1u);
            const unsigned tg = og / nx;
            if (og + 1u == (tg + 1u) * nx) xb_add(&bar[XB_TOPGEN], 1u);
            else XB_SPIN(xb_ld(&bar[XB_TOPGEN]) == tg, bar);
            __builtin_amdgcn_fence(__ATOMIC_ACQUIRE, "agent");
            xb_add(&bar[XB_XGEN(b.x)], 1u);
            asm volatile("s_waitcnt vmcnt(0)" ::: "memory");
        } else {
            asm volatile("buffer_inv sc1" ::: "memory");
            XB_SPIN(xb_ld(&bar[XB_XGEN(b.x)]) == gen, bar);
            asm volatile("s_waitcnt vmcnt(0)" ::: "memory");
        }
    }
    __syncthreads();
}

typedef const Params __attribute__((address_space(4))) CParams;
DI CParams* params_opaque() { unsigned long long p = (unsigned long long)__builtin_amdgcn_kernarg_segment_ptr(); asm volatile("" : "+s"(p)); return (CParams*)p; }
#define WSPTR(T, off) ((T*)(ws + (off)))

DI void phase_prologue(LAS unsigned char* lds) {
    CParams* P = params_opaque();
    const int tid = tid_opaque(), bid = blockIdx.x, G = gridDim.x, wave = tid >> 6, lane = tid & 63;
    unsigned char* ws = P->ws;
    float* pattn = WSPTR(float, WS_PATTN);
    {
        const float* x = P->x; bf16_t* xb = WSPTR(bf16_t, WS_XB);
        for (int row = bid * 8 + wave; row < S; row += G * 8) {
            const float* xr = x + (size_t)row * DM; float ss = 0.f;
#pragma unroll
            for (int j = 0; j < 8; ++j) { const f32x4 v = *(const f32x4*)(xr + 4 * lane + 256 * j); ss += (v[0] * v[0] + v[1] * v[1]) + (v[2] * v[2] + v[3] * v[3]);
                u32x2 o; o.x = pk2(v[0], v[1]); o.y = pk2(v[2], v[3]); *(u32x2*)(xb + (size_t)row * DM + 4 * lane + 256 * j) = o; }
#pragma unroll
            for (int o = 1; o < 64; o <<= 1) ss += __shfl_xor(ss, o);
            if (lane < 32) pattn[(size_t)row * 32 + lane] = lane == 0 ? ss : 0.f;
        }
    }
    LAS float* tile = (LAS float*)lds;
    int off = 0;
#pragma unroll 1
    for (int l = 0; l < NL; ++l) {
        unsigned char* wl = ws + WS_W + (size_t)l * W_LAYER;
        convert_T(tile, (bf16_t*)(wl + WO_IN), DM, DINP, DIN, P->attn_norm + l * DM, ColMapIn{P->w_in + (size_t)l * DM * DIN}, bid, G, off);
        convert_T(tile, (bf16_t*)(wl + WO_UQ), 512, NQ, 1152, P->q_norm + l * 512, ColMapUq{P->w_uq + (size_t)l * 512 * 1152}, bid, G, off);
        convert_T(tile, (bf16_t*)(wl + WO_K), 512, 768, 1536, P->kv_norm + l * 512, ColMapKv{P->w_ukv + (size_t)l * 512 * 1536, 0}, bid, G, off);
        convert_T(tile, (bf16_t*)(wl + WO_V), 512, 768, 1536, P->kv_norm + l * 512, ColMapKv{P->w_ukv + (size_t)l * 512 * 1536, 128}, bid, G, off);
        convert_T(tile, (bf16_t*)(wl + WO_OUT), DM, DM, DM, nullptr, ColMapId{P->w_out + (size_t)l * DM * DM}, bid, G, off);
        convert_T(tile, (bf16_t*)(wl + WO_GU), DM, 2 * DFF, DFF, P->ffn_norm + l * DM, ColMapGu{P->w_gate + (size_t)l * DM * DFF, P->w_up + (size_t)l * DM * DFF}, bid, G, off);
        convert_T(tile, (bf16_t*)(wl + WO_DN), DFF, DM, DM, nullptr, ColMapId{P->w_down + (size_t)l * DFF * DM}, bid, G, off);
    }
    {
        float* cosr = WSPTR(float, WS_COSR); float* sinr = WSPTR(float, WS_SINR); float* cosm = WSPTR(float, WS_COSM); float* sinm = WSPTR(float, WS_SINM);
        const int* pos = P->pos;
        for (int i = bid * 512 + tid; i < S * 96; i += G * 512) {
            const int s = i / 96, j = i % 96;
            const float ps = (float)pos[s];
            float inv; if (j < 64) inv = 1.0f / powf(10000.f, (float)(2 * j) / 128.f); else inv = 1.0f / powf(10000.f, (float)(2 * (j - 64)) / 64.f);
            const float ang = ps * inv;
            const double a = (double)ang; const double nrev = rint(a * 0.15915494309189535); const float red = (float)(a - nrev * 6.283185307179586);
            const float c = cosf(red), sn = sinf(red);
            if (j < 64) { cosr[s * 64 + j] = c; sinr[s * 64 + j] = sn; } else { cosm[s * 32 + j - 64] = c; sinm[s * 32 + j - 64] = sn; }
        }
    }
}

DI void phase_A(LAS unsigned char* lds, int l) {
    CParams* P = params_opaque(); unsigned char* ws = P->ws; const int bid = blockIdx.x, G = gridDim.x;
    pg8::Gemm g{WSPTR(bf16_t, WS_XB), (const bf16_t*)(ws + WS_W + (size_t)l * W_LAYER + WO_IN), S, DINP, DM, DM, DM}; pg8::StaticOrder so; so.init(S, DINP, G, bid);
    EpiIn E{WSPTR(bf16_t, WS_Z), WSPTR(float, WS_PATTN), WSPTR(float, WS_PCQ), WSPTR(float, WS_PCKV), WSPTR(float, WS_COSR), WSPTR(float, WS_SINR), WSPTR(float, WS_COSM), WSPTR(float, WS_SINM)};
    pg8::gemm_phase(lds, g, so, E);
}
DI void phase_B1(LAS unsigned char* lds, int l) {
    CParams* P = params_opaque(); unsigned char* ws = P->ws; const int bid = blockIdx.x, G = gridDim.x;
    float* ssq_cq = WSPTR(float, WS_PCQ);
    pg8::Gemm g{WSPTR(bf16_t, WS_Z) + Z_CQ, (const bf16_t*)(ws + WS_W + (size_t)l * W_LAYER + WO_UQ), S, NQ, 512, DINP, 512}; pg8::StaticOrder so; so.init(S, NQ, G, bid);
    EpiQ E{WSPTR(bf16_t, WS_MQ), ssq_cq, WSPTR(float, WS_COSM), WSPTR(float, WS_SINM)}; pg8::gemm_phase(lds, g, so, E);
}
DI void phase_B2(LAS unsigned char* lds, int l) {
    CParams* P = params_opaque(); unsigned char* ws = P->ws; const int bid = blockIdx.x, G = gridDim.x;
    float* ssq_ckv = WSPTR(float, WS_PCKV);
    pg8::Gemm g{WSPTR(bf16_t, WS_Z) + Z_CKV, (const bf16_t*)(ws + WS_W + (size_t)l * W_LAYER + WO_K), S, NKV, 512, DINP, 512}; pg8::StaticOrder so; so.init(S, NKV, G, (bid + 64) % G);
    EpiRowScale E{WSPTR(bf16_t, WS_KN), NKV, ssq_ckv, 1.f / 512.f}; pg8::gemm_phase(lds, g, so, E);
}
DI void phase_B3(LAS unsigned char* lds, int l) {
    CParams* P = params_opaque(); unsigned char* ws = P->ws; const int bid = blockIdx.x, G = gridDim.x;
    float* ssq_ckv = WSPTR(float, WS_PCKV);
    pg8::Gemm g{(const bf16_t*)(ws + WS_W + (size_t)l * W_LAYER + WO_V), WSPTR(bf16_t, WS_Z) + Z_CKV, NKV, S, 512, 512, DINP}; pg8::StaticOrder so; so.init(NKV, S, G, (bid + 128) % G);
    EpiColScale E{WSPTR(bf16_t, WS_VT), S, ssq_ckv, 1.f / 512.f}; pg8::gemm_phase(lds, g, so, E);
}
DI void phase_B4(LAS unsigned char* lds, int l) {
    CParams* P = params_opaque(); unsigned char* ws = P->ws;
    volatile LAS unsigned* slot = (volatile LAS unsigned*)(lds + LDS_BYTES - 8);
    unsigned* counter = (unsigned*)(ws + WS_SSQ) + 3840 + l * 64;
    for (;;) {
        __syncthreads();
        if (threadIdx.x == 0) *slot = atomicAdd(counter, 1u);
        __syncthreads();
        const int u = (int)*slot;
        if (u >= 640) break;
        if (u < 384) ret_kv_unit(lds, u / 6, u % 6, WSPTR(bf16_t, WS_Z), WSPTR(float, WS_KVT));
        else { const int v = u - 384; gmlp_unit(lds, v >> 2, v & 3, WSPTR(bf16_t, WS_Z), P->w_s + (size_t)l * 4 * 16384, P->b_s + l * 512, P->gv_norm + l * 512, P->mix_norm + l * DM, WSPTR(bf16_t, WS_Y)); }
    }
}
DI void phase_C(LAS unsigned char* lds, int l) {
    CParams* P = params_opaque(); unsigned char* ws = P->ws; const int bid = blockIdx.x, G = gridDim.x;
    {
        const int tid = tid_opaque(); const float* kvT = WSPTR(float, WS_KVT); bf16_t* prevT = WSPTR(bf16_t, WS_PREVT);
        for (int e = bid * 512 + tid; e < 6 * 16384; e += G * 512) {
            const int h = e >> 14, ed = e & 16383;
            const float decay = __expf(ret_log_gamma(h) * 128.f);
            float st = 0.f;
            for (int n = 0; n < 64; ++n) { const size_t idx = ((size_t)(n * 6 + h) << 14) + ed; prevT[idx] = (bf16_t)f2bf(st); st = decay * st + kvT[idx]; }
        }
    }
    {
        volatile LAS unsigned* slot = (volatile LAS unsigned*)(lds + LDS_BYTES - 8);
        unsigned* counter = (unsigned*)(ws + WS_SSQ) + 3584 + l * 64;
        float* apart = WSPTR(float, WS_APART);
        for (;;) {
            __syncthreads();
            if (threadIdx.x == 0) *slot = atomicAdd(counter, 1u);
            __syncthreads();
            const int u = (int)*slot;
            if (u >= 480) break;
            const int h = u % 6; const unsigned e = ATT_UNITS[u / 6];
            const int qb = e & 31, s0 = (e >> 5) & 255, s1 = (e >> 13) & 255, rec = (int)(e >> 21);
            float* part = rec ? apart + (size_t)(h * 72 + rec - 1) * APART_REC : nullptr;
            attn_unit(lds, h, qb, s0, s1, part, WSPTR(bf16_t, WS_MQ), WSPTR(bf16_t, WS_KN), WSPTR(bf16_t, WS_Z), WSPTR(bf16_t, WS_VT), P->mix_norm + l * DM, WSPTR(bf16_t, WS_Y));
        }
    }
}
DI void phase_D(LAS unsigned char* lds, int l) {
    CParams* P = params_opaque(); unsigned char* ws = P->ws; const int bid = blockIdx.x, G = gridDim.x;
    {
        const int tid = tid_opaque(), gw = bid * 8 + (tid >> 6), lane = tid & 63; const float* apart = WSPTR(float, WS_APART);
        const int nw = G * 8, gsh = (gw + nw - (nw >> 1)) % nw;
        for (int j = gsh; j < 1152; j += nw) { const int w = j & 7, t = j >> 3, h = t / 24, qb = 8 + t % 24, k = (qb + 8) >> 3;
            const int base = qb < 16 ? (qb - 8) * 2 : qb < 24 ? 16 + (qb - 16) * 3 : 40 + (qb - 24) * 4;
            attn_combine_wave(apart + (size_t)(h * 72 + base) * APART_REC + (size_t)w * 34 * 64, k, h, 256 * qb + 32 * w, lane, P->mix_norm + l * DM, WSPTR(bf16_t, WS_Y)); }
    }
    for (int u = bid; u < 384; u += G) ret_out_unit(lds, u / 6, u % 6, WSPTR(bf16_t, WS_Z), WSPTR(bf16_t, WS_PREVT), P->mix_norm + l * DM, WSPTR(bf16_t, WS_Y));
}
DI void phase_E(LAS unsigned char* lds, int l) {
    CParams* P = params_opaque(); unsigned char* ws = P->ws; const int bid = blockIdx.x, G = gridDim.x;
    pg8::Gemm g{WSPTR(bf16_t, WS_Y), (const bf16_t*)(ws + WS_W + (size_t)l * W_LAYER + WO_OUT), S, DM, DM, DM, DM}; pg8::StaticOrder so; so.init(S, DM, G, bid);
    EpiResid E{WSPTR(bf16_t, WS_XB), WSPTR(float, WS_PFFN)};
    pg8::gemm_phase(lds, g, so, E);
}
DI void phase_F(LAS unsigned char* lds, int l) {
    CParams* P = params_opaque(); unsigned char* ws = P->ws; const int bid = blockIdx.x, G = gridDim.x;
    pg8::Gemm g{WSPTR(bf16_t, WS_XB), (const bf16_t*)(ws + WS_W + (size_t)l * W_LAYER + WO_GU), S, 2 * DFF, DM, DM, DM}; pg8::StaticOrder so; so.init(S, 2 * DFF, G, bid);
    EpiGLU E{WSPTR(bf16_t, WS_HID), WSPTR(float, WS_PFFN)};
    pg8::gemm_phase(lds, g, so, E);
}
DI void phase_G(LAS unsigned char* lds, int l) {
    CParams* P = params_opaque(); unsigned char* ws = P->ws; const int bid = blockIdx.x, G = gridDim.x;
    pg8::Gemm g{WSPTR(bf16_t, WS_HID), (const bf16_t*)(ws + WS_W + (size_t)l * W_LAYER + WO_DN), S, DM, DFF, DFF, DFF}; pg8::StaticOrder so; so.init(S, DM, G, bid);
    EpiResid E{WSPTR(bf16_t, WS_XB), WSPTR(float, WS_PATTN)};
    pg8::gemm_phase(lds, g, so, E);
}
DI void phase_final() {
    CParams* P = params_opaque(); unsigned char* ws = P->ws; const int bid = blockIdx.x, G = gridDim.x;
    const int tid = tid_opaque(), wave = tid >> 6, lane = tid & 63;
    const float* sf = WSPTR(float, WS_PATTN); const bf16_t* xb = WSPTR(bf16_t, WS_XB); const float* fn = P->final_norm; float* out = P->out;
    for (int row = bid * 8 + wave; row < S; row += G * 8) {
        float tot = sf[(size_t)row * 32 + (lane & 31)];
#pragma unroll
        for (int o = 1; o < 32; o <<= 1) tot += __shfl_xor(tot, o);
        const float rs = rsqrtf(tot * (1.f / DM) + EPS);
#pragma unroll
        for (int j = 0; j < 8; ++j) { const int c = 4 * lane + 256 * j; const u32x2 v = *(const u32x2*)(xb + (size_t)row * DM + c); const f32x4 gn = *(const f32x4*)(fn + c);
            f32x4 o; o[0] = bflo(v.x) * rs * gn[0]; o[1] = bfhi(v.x) * rs * gn[1]; o[2] = bflo(v.y) * rs * gn[2]; o[3] = bfhi(v.y) * rs * gn[3];
            *(f32x4*)(out + (size_t)row * DM + c) = o; }
    }
}

__global__ void __launch_bounds__(512, 2) fwd_megakernel(Params Pbyval) {
    extern __shared__ __attribute__((aligned(16))) unsigned char smem[];
    LAS unsigned char* lds = (LAS unsigned char*)smem;
    cg::grid_group grid = cg::this_grid();
    volatile LAS unsigned* bst = (volatile LAS unsigned*)(lds + LDS_BYTES - 16);
    if (threadIdx.x < 4) bst[threadIdx.x] = 0u;
    __syncthreads();
    { CParams* P = params_opaque(); (void)xcd_barrier_post((unsigned*)(P->ws + WS_SSQ), bst); }
#define GSYNC() do { CParams* Pb_ = params_opaque(); XcdBarrier b_; b_.bar = (unsigned*)(Pb_->ws + WS_SSQ); b_.x = xb_xcc_id(); b_.st = (volatile LAS unsigned*)(lds + LDS_BYTES - 16); xcd_barrier(b_); } while (0)
    phase_prologue(lds);
    asm volatile("s_waitcnt vmcnt(0) lgkmcnt(0)" ::: "memory"); grid.sync();
#pragma unroll 1
    for (int l = 0; l < NL; ++l) {
        phase_A(lds, l);
        GSYNC();
        phase_B1(lds, l); phase_B2(lds, l); phase_B3(lds, l); phase_B4(lds, l);
        GSYNC();
        phase_C(lds, l);
        GSYNC();
        phase_D(lds, l);
        GSYNC();
        phase_E(lds, l);
        GSYNC();
        phase_F(lds, l);
        GSYNC();
        phase_G(lds, l);
        GSYNC();
    }
    phase_final();
}

extern "C" void kernel_launch(void* const* d_in, const int* in_sizes, int n_in, void* d_out, int out_size, void* d_ws, size_t ws_size, hipStream_t stream) {
    static int grid_blocks = 0;
    if (grid_blocks == 0) {
        if (n_in != 18 || out_size != S * DM || ws_size < WS_END) { fprintf(stderr, "kernel_launch: unexpected problem (n_in %d out %d ws %zu need %zu)\n", n_in, out_size, ws_size, (size_t)WS_END); grid_blocks = -1; return; }
        int dev = 0, cus = 0, per_cu = 0;
        hipGetDevice(&dev);
        hipDeviceGetAttribute(&cus, hipDeviceAttributeMultiprocessorCount, dev);
        hipFuncSetAttribute((const void*)fwd_megakernel, hipFuncAttributeMaxDynamicSharedMemorySize, LDS_BYTES);
        hipOccupancyMaxActiveBlocksPerMultiprocessor(&per_cu, (const void*)fwd_megakernel, 512, LDS_BYTES);
        if (per_cu < 1) { fprintf(stderr, "kernel_launch: occupancy query returned %d\n", per_cu); per_cu = 1; }
        grid_blocks = cus * per_cu;
    }
    if (grid_blocks < 0) return;
    Params p{};
    p.x = (const float*)d_in[0]; p.pos = (const int*)d_in[1]; p.attn_norm = (const float*)d_in[2]; p.w_in = (const float*)d_in[3]; p.q_norm = (const float*)d_in[4];
    p.w_uq = (const float*)d_in[5]; p.kv_norm = (const float*)d_in[6]; p.w_ukv = (const float*)d_in[7]; p.gv_norm = (const float*)d_in[8]; p.w_s = (const float*)d_in[9];
    p.b_s = (const float*)d_in[10]; p.mix_norm = (const float*)d_in[11]; p.w_out = (const float*)d_in[12]; p.ffn_norm = (const float*)d_in[13]; p.w_gate = (const float*)d_in[14];
    p.w_up = (const float*)d_in[15]; p.w_down = (const float*)d_in[16]; p.final_norm = (const float*)d_in[17]; p.out = (float*)d_out; p.ws = (unsigned char*)d_ws;
    if (hipMemsetAsync((char*)d_ws + WS_SSQ, 0, 16384, stream) != hipSuccess) { fprintf(stderr, "kernel_launch: memset of barrier words failed\n"); return; }
    void* args[] = {&p};
    hipError_t e = hipLaunchCooperativeKernel((const void*)fwd_megakernel, dim3(grid_blocks), dim3(512), args, LDS_BYTES, stream);
    if (e != hipSuccess) fprintf(stderr, "cooperative launch failed: %s (grid %d)\n", hipGetErrorString(e), grid_blocks);
}
```

```cpp
#include <hip/hip_runtime.h>
#include <hip/hip_cooperative_groups.h>
#include <cstdint>
#include <cstdio>
namespace cg = cooperative_groups;

#define LAS __attribute__((address_space(3)))
#define DI __device__ __forceinline__
typedef unsigned short bf16_t;
typedef short bf16x8 __attribute__((ext_vector_type(8)));
typedef short s16x4 __attribute__((ext_vector_type(4)));
typedef float f32x4 __attribute__((ext_vector_type(4)));
typedef float f32x16 __attribute__((ext_vector_type(16)));
typedef unsigned u32x4 __attribute__((ext_vector_type(4)));
typedef unsigned u32x2 __attribute__((ext_vector_type(2)));

constexpr int S = 8192, DM = 2048, NL = 4, DIN = 5184, DINP = 5376, DFF = 5632, NQ = 1280, NKV = 768;
constexpr int Z_RQ = 0, Z_RK = 768, Z_RV = 1536, Z_RG = 2304, Z_CQ = 3072, Z_CKV = 3584, Z_GU = 4096, Z_GV = 4608, Z_KPE = 5120;
constexpr float EPS = 1e-6f;
constexpr float QSCALE = 0.07216878364870322f * 1.4426950408889634f;
constexpr float KSCALE_RET = 0.08838834764831845f;

constexpr size_t MiB = 1u << 20;
constexpr size_t WS_SSQ = 0;
constexpr size_t WS_COSR = 1 * MiB, WS_SINR = 3 * MiB, WS_COSM = 5 * MiB, WS_SINM = 6 * MiB;
constexpr size_t WS_W = 8 * MiB, W_LAYER = 98 * MiB;
constexpr size_t WO_IN = 0, WO_UQ = 21 * MiB, WO_K = 21 * MiB + 1280 * 1024, WO_V = WO_K + 768 * 1024, WO_OUT = 23 * MiB + 768 * 1024, WO_GU = WO_OUT + 8 * MiB, WO_DN = WO_GU + 44 * MiB;
static_assert(WO_DN + 22 * MiB <= W_LAYER, "weights layer");
constexpr size_t WS_XRES = WS_W + 4 * W_LAYER;
constexpr size_t WS_XB = WS_XRES + 64 * MiB;
constexpr size_t WS_Z = WS_XB + 32 * MiB;
constexpr size_t WS_MQ = WS_Z + 84 * MiB;
constexpr size_t WS_HID = WS_Z;
constexpr size_t WS_KN = WS_MQ + 20 * MiB;
constexpr size_t WS_VT = WS_KN + 12 * MiB;
constexpr size_t WS_Y = WS_VT + 12 * MiB;
constexpr size_t WS_KVT = WS_Y + 32 * MiB;
constexpr size_t WS_PREVT = WS_KVT + 24 * MiB;
constexpr size_t WS_PATTN = WS_PREVT + 12 * MiB;
constexpr size_t WS_PFFN = WS_PATTN + 1 * MiB;
constexpr size_t WS_PCQ = WS_PFFN + 1 * MiB;
constexpr size_t WS_PCKV = WS_PCQ + 1 * MiB;
constexpr size_t WS_APART = WS_PCKV + 1 * MiB;
constexpr size_t APART_REC = 8 * 34 * 64;
constexpr size_t WS_END = WS_APART + 56 * MiB;
static_assert((size_t)S * DFF * 2 <= 104 * MiB, "hid overlay");
static_assert(432 * APART_REC * 4 <= 56 * MiB, "attention partials");

constexpr int LDS_BYTES = 147456;

struct Params {
    const float* x; const int* pos; const float* attn_norm; const float* w_in; const float* q_norm; const float* w_uq; const float* kv_norm; const float* w_ukv;
    const float* gv_norm; const float* w_s; const float* b_s; const float* mix_norm; const float* w_out; const float* ffn_norm; const float* w_gate; const float* w_up;
    const float* w_down; const float* final_norm; float* out; unsigned char* ws;
};

DI unsigned f2bf(float f) { unsigned u = __builtin_bit_cast(unsigned, f); return (u + 0x7fffu + ((u >> 16) & 1u)) >> 16; }
typedef float f32x2_t __attribute__((ext_vector_type(2))); typedef __bf16 bf16x2_t __attribute__((ext_vector_type(2)));
DI unsigned pk2(float lo, float hi) { const f32x2_t v = {lo, hi}; const bf16x2_t b = __builtin_convertvector(v, bf16x2_t); return __builtin_bit_cast(unsigned, b); }
DI float max3f(float a, float b, float c) { float r; asm("v_max3_f32 %0, %1, %2, %3" : "=v"(r) : "v"(a), "v"(b), "v"(c)); return r; }
DI float half_max(float m) { auto rr = __builtin_amdgcn_permlane32_swap(__float_as_uint(m), __float_as_uint(m), false, false); return fmaxf(__uint_as_float(rr[0]), __uint_as_float(rr[1])); }
DI float half_sum(float m) { auto rr = __builtin_amdgcn_permlane32_swap(__float_as_uint(m), __float_as_uint(m), false, false); return __uint_as_float(rr[0]) + __uint_as_float(rr[1]); }
DI float bf2f(unsigned short b) { return __builtin_bit_cast(float, (unsigned)b << 16); }
DI float bflo(unsigned w) { return __builtin_bit_cast(float, w << 16); }
DI float bfhi(unsigned w) { return __builtin_bit_cast(float, w & 0xffff0000u); }
DI float gelu_tanh(float x) { const float u = 0.7978845608028654f * (x + 0.044715f * x * x * x); const float e = __builtin_amdgcn_exp2f(2.885390081777927f * u); const float t = 1.f - 2.f * __builtin_amdgcn_rcpf(e + 1.f); return 0.5f * x * (1.f + t); }
DI float silu(float x) { return x * __builtin_amdgcn_rcpf(1.f + __builtin_amdgcn_exp2f(-1.4426950408889634f * x)); }
DI int tid_opaque() { int t = threadIdx.x; asm volatile("" : "+v"(t)); return t; }
DI int sgpr_opaque(int v) { asm volatile("" : "+s"(v)); return v; }

namespace pg8 {
constexpr int BM = 256, BK = 64, HALF = 128, HTB = HALF * BK * 2, STAGE_BYTES = 8 * HTB, NXCD = 8, WGM = 8;
__host__ __device__ __forceinline__ int lds_byte(int r, int c) { const int st = (r >> 4) * 2 + (c >> 5), rr = r & 15, cc = c & 31, ob = rr * 64 + cc * 2; return st * 1024 + (ob ^ (((ob >> 9) & 1) << 5)); }
__host__ __device__ __forceinline__ void stage_rc(int b, int& R, int& C) { const int st = b / 1024, sb = b % 1024, swz = sb ^ (((sb >> 9) & 1) << 5); R = (st >> 1) * 16 + swz / 64; C = (st & 1) * 32 + (swz % 64) / 2; }
__host__ __device__ __forceinline__ int perm32(int rho) { const int n = rho >> 4, i = rho & 15; return 8 * (i >> 2) + 4 * n + (i & 3); }
struct Unit { int pm, pn; };
struct Gemm { const bf16_t* A; const bf16_t* Bt; int M, N, K, lda, ldb; };
struct StaticOrder {
    int nM, nN, nwg, G, c;
    __device__ void init(int M, int N, int G_, int c_) { nM = M / BM; nN = N / BM; nwg = nM * nN; G = G_; c = c_; }
    __device__ bool next(int i, Unit& u) const {
        const long L = (long)i * G + c; if (L >= nwg) return false;
        int wgid = (int)L; { const int q = nwg / NXCD, r = nwg % NXCD, xcd = wgid % NXCD, off = wgid / NXCD; wgid = (xcd < r ? xcd * (q + 1) : r * (q + 1) + (xcd - r) * q) + off; }
        const int nig = WGM * nN, gid = wgid / nig, fm = gid * WGM, gsz = (nM - fm) < WGM ? (nM - fm) : WGM;
        u.pm = fm + ((wgid % nig) % gsz); u.pn = (wgid % nig) / gsz; return true;
    }
};

template <class Epi>
__device__ __forceinline__ void gemm_phase(LAS unsigned char* lds, const Gemm g, const StaticOrder& S, const Epi& E) {
    const int tid = tid_opaque(), wid = __builtin_amdgcn_readfirstlane(tid >> 6), lane = tid & 63, wr = wid >> 2, wc = wid & 3, fr = lane & 15, fq = lane >> 4;
    const int K = g.K, nt = K / BK;
    unsigned voffA[2], voffB[2];
#pragma unroll
    for (int i = 0; i < 2; ++i) { int R, C; stage_rc(tid * 16 + i * 8192, R, C); const int Rb = Epi::PERM ? ((R & ~31) + perm32(R & 31)) : R;
        voffA[i] = (unsigned)(R * g.lda + C) * 2u; voffB[i] = (unsigned)(Rb * g.ldb + C) * 2u; }
    const size_t kstep = (size_t)(BK * 2);
    const size_t hstepA = (size_t)HALF * g.lda * 2, hstepB = (size_t)HALF * g.ldb * 2;
    const size_t tstepA = 2 * hstepA, tstepB = 2 * hstepB;
    const unsigned ldsw = (unsigned)wid * 1024u;
    const int aoff = lds_byte(wr * 64 + fr, fq * 8), boff = lds_byte(wc * 32 + fr, fq * 8);
#define PG8_SA(b, h) (((b) * 2 + (h)) * HTB)
#define PG8_SB(b, h) ((4 + (b) * 2 + (h)) * HTB)
#define PG8_STAGE(bufoff, gbase, voff) do { _Pragma("unroll") for (int _i = 0; _i < 2; ++_i) \
        __builtin_amdgcn_global_load_lds((const unsigned*)((const char*)(gbase) + (voff)[_i]), (LAS unsigned*)(lds + (bufoff) + ldsw + _i * 8192), 16, 0, 0); } while (0)
#define PG8_LDA(dst, b, h) do { _Pragma("unroll") for (int m = 0; m < 4; ++m) _Pragma("unroll") for (int k = 0; k < 2; ++k) dst[m][k] = *(const LAS bf16x8*)(lds + PG8_SA(b, h) + aoff + m * 2048 + k * 1024); } while (0)
#define PG8_LDB(dst, b, h) do { _Pragma("unroll") for (int n = 0; n < 2; ++n) _Pragma("unroll") for (int k = 0; k < 2; ++k) dst[n][k] = *(const LAS bf16x8*)(lds + PG8_SB(b, h) + boff + n * 2048 + k * 1024); } while (0)
#define PG8_MMA(ai, bj, At, Bt) do { __builtin_amdgcn_s_setprio(1); _Pragma("unroll") for (int m = 0; m < 4; ++m) _Pragma("unroll") for (int n = 0; n < 2; ++n) _Pragma("unroll") for (int k = 0; k < 2; ++k) \
        acc[ai][bj][m][n] = __builtin_amdgcn_mfma_f32_16x16x32_bf16(Bt[n][k], At[m][k], acc[ai][bj][m][n], 0, 0, 0); __builtin_amdgcn_s_setprio(0); } while (0)
#define PG8_WAIT_V(n) asm volatile("s_waitcnt vmcnt(" #n ")" ::: "memory")
#define PG8_WAIT_L(n) asm volatile("s_waitcnt lgkmcnt(" #n ")" ::: "memory")
#define PG8_BAR __builtin_amdgcn_s_barrier()
#define PG8_SCHED __builtin_amdgcn_sched_barrier(0)
    Unit cur, nxt; int ui = 0;
    if (!S.next(0, cur)) return;
    f32x4 acc[2][2][4][2];
#pragma unroll
    for (int a = 0; a < 2; ++a)
#pragma unroll
        for (int b = 0; b < 2; ++b)
#pragma unroll
            for (int m = 0; m < 4; ++m)
#pragma unroll
                for (int n = 0; n < 2; ++n) acc[a][b][m][n] = (f32x4){0.f, 0.f, 0.f, 0.f};
    bf16x8 At[4][2], B0[2][2], B1[2][2];
    const char* cA = (const char*)g.A + (size_t)cur.pm * tstepA; const char* cB = (const char*)g.Bt + (size_t)cur.pn * tstepB;
    PG8_STAGE(PG8_SB(0, 0), cB, voffB); PG8_STAGE(PG8_SB(0, 1), cB + hstepB, voffB); PG8_STAGE(PG8_SA(0, 0), cA, voffA); PG8_STAGE(PG8_SA(0, 1), cA + hstepA, voffA);
    if (wr == 1) PG8_BAR;
    PG8_WAIT_V(2); PG8_BAR;
    PG8_STAGE(PG8_SB(1, 0), cB + kstep, voffB); PG8_STAGE(PG8_SA(1, 0), cA + kstep, voffA); PG8_STAGE(PG8_SB(1, 1), cB + hstepB + kstep, voffB);
    PG8_WAIT_V(6); PG8_BAR;
    for (;;) {
        const bool has_next = S.next(ui + 1, nxt);
        const char* nA = has_next ? (const char*)g.A + (size_t)nxt.pm * tstepA : cA; const char* nB = has_next ? (const char*)g.Bt + (size_t)nxt.pn * tstepB : cB;
        for (int t = 0; t < nt; t += 2) {
            const bool last = (t == nt - 2);
            const char* a1 = cA + (size_t)(t + 1) * kstep;
            const char* a2 = last ? nA : cA + (size_t)(t + 2) * kstep; const char* b2 = last ? nB : cB + (size_t)(t + 2) * kstep;
            const char* a3 = a2 + kstep; const char* b3 = b2 + kstep;
            PG8_LDB(B0, 0, 0); PG8_LDB(B1, 0, 1); PG8_SCHED; PG8_LDA(At, 0, 0); PG8_STAGE(PG8_SA(1, 1), a1 + hstepA, voffA);
            PG8_WAIT_V(8); PG8_WAIT_L(0); PG8_BAR; PG8_MMA(0, 0, At, B0); PG8_MMA(0, 1, At, B1); PG8_BAR; PG8_SCHED;
            PG8_LDA(At, 0, 1); PG8_STAGE(PG8_SB(0, 0), b2, voffB); PG8_STAGE(PG8_SB(0, 1), b2 + hstepB, voffB); PG8_STAGE(PG8_SA(0, 0), a2, voffA);
            PG8_WAIT_V(8); PG8_WAIT_L(0); PG8_BAR; PG8_MMA(1, 0, At, B0); PG8_MMA(1, 1, At, B1); PG8_BAR; PG8_SCHED;
            PG8_LDB(B0, 1, 0); PG8_LDB(B1, 1, 1); PG8_SCHED; PG8_LDA(At, 1, 0); PG8_STAGE(PG8_SA(0, 1), a2 + hstepA, voffA);
            PG8_WAIT_V(8); PG8_WAIT_L(0); PG8_BAR; PG8_MMA(0, 0, At, B0); PG8_MMA(0, 1, At, B1); PG8_BAR; PG8_SCHED;
            PG8_LDA(At, 1, 1); PG8_STAGE(PG8_SB(1, 0), b3, voffB); PG8_STAGE(PG8_SB(1, 1), b3 + hstepB, voffB); PG8_STAGE(PG8_SA(1, 0), a3, voffA);
            PG8_WAIT_V(8); PG8_WAIT_L(0); PG8_BAR; PG8_MMA(1, 0, At, B0); PG8_MMA(1, 1, At, B1); PG8_BAR; PG8_SCHED;
        }
        if (wr == 0) PG8_BAR;
        E(acc, cur, wr, wc, fr, fq);
        PG8_WAIT_V(0);
        if (!has_next) break;
#pragma unroll
        for (int a = 0; a < 2; ++a)
#pragma unroll
            for (int b = 0; b < 2; ++b)
#pragma unroll
                for (int m = 0; m < 4; ++m)
#pragma unroll
                    for (int n = 0; n < 2; ++n) acc[a][b][m][n] = (f32x4){0.f, 0.f, 0.f, 0.f};
        cur = nxt; cA = nA; cB = nB; ++ui;
        if (wr == 1) PG8_BAR;
    }
    PG8_WAIT_V(0);
    PG8_BAR;
#undef PG8_SA
#undef PG8_SB
#undef PG8_STAGE
#undef PG8_LDA
#undef PG8_LDB
#undef PG8_MMA
#undef PG8_WAIT_V
#undef PG8_WAIT_L
#undef PG8_BAR
#undef PG8_SCHED
}
}

typedef f32x4 Acc[2][2][4][2];
DI u32x4 pack8(const float* v) { u32x4 w; w.x = pk2(v[0], v[1]); w.y = pk2(v[2], v[3]); w.z = pk2(v[4], v[5]); w.w = pk2(v[6], v[7]); return w; }
DI float quad_sum(float s) { s += __shfl_xor(s, 16); s += __shfl_xor(s, 32); return s; }

DI float rowsum32(const float* part, int row, int fq) {
    const f32x4 a = *(const f32x4*)(part + (size_t)row * 32 + 8 * fq), b = *(const f32x4*)(part + (size_t)row * 32 + 8 * fq + 4);
    return quad_sum(((a[0] + a[1]) + (a[2] + a[3])) + ((b[0] + b[1]) + (b[2] + b[3])));
}
DI float rowsum8(const float* part, int row, int fq) {
    const float a = part[(size_t)row * 8 + 2 * fq], b = part[(size_t)row * 8 + 2 * fq + 1];
    return quad_sum(a + b);
}
DI float rowsum8_full(const float* part, int row) {
    const f32x4 a = *(const f32x4*)(part + (size_t)row * 8), b = *(const f32x4*)(part + (size_t)row * 8 + 4);
    return ((a[0] + a[1]) + (a[2] + a[3])) + ((b[0] + b[1]) + (b[2] + b[3]));
}
struct EpiIn {
    static constexpr bool PERM = true;
    bf16_t* z; const float* ssq_in; float* ssq_cq; float* ssq_ckv; const float* cosr; const float* sinr; const float* cosm; const float* sinm;
    DI void operator()(const Acc& acc, const pg8::Unit& u, int wr, int wc, int fr, int fq) const {
        const int pn = u.pn;
        const int mode = pn < 3 ? 0 : pn < 6 ? 1 : pn < 12 ? 2 : pn < 14 ? 3 : pn < 16 ? 4 : pn < 20 ? 5 : 6;
#pragma unroll
        for (int ai = 0; ai < 2; ++ai)
#pragma unroll
            for (int m = 0; m < 4; ++m) {
                const int row = u.pm * 256 + ai * 128 + wr * 64 + m * 16 + fr;
                const float rs = rsqrtf(rowsum32(ssq_in, row, fq) * (1.f / DM) + EPS);
                float ss = 0.f;
#pragma unroll
                for (int bj = 0; bj < 2; ++bj) {
                    const int c0 = pn * 256 + bj * 128 + wc * 32 + 8 * fq;
                    float v[8];
#pragma unroll
                    for (int i = 0; i < 4; ++i) { v[i] = acc[ai][bj][m][0][i] * rs; v[4 + i] = acc[ai][bj][m][1][i] * rs; }
                    if (mode <= 1) {
                        const int d0 = ((c0 & 127) >> 3) * 4;
                        const f32x4 cs = *(const f32x4*)(cosr + (size_t)row * 64 + d0), sn = *(const f32x4*)(sinr + (size_t)row * 64 + d0);
                        const float sc = mode == 1 ? KSCALE_RET : 1.f;
#pragma unroll
                        for (int i = 0; i < 4; ++i) { const float x1 = v[i], x2 = v[4 + i]; v[i] = (x1 * cs[i] - x2 * sn[i]) * sc; v[4 + i] = (x2 * cs[i] + x1 * sn[i]) * sc; }
                    } else if (mode == 3 || mode == 4) {
#pragma unroll
                        for (int i = 0; i < 8; ++i) ss += v[i] * v[i];
                    } else if (mode == 5) {
#pragma unroll
                        for (int i = 0; i < 8; ++i) v[i] = gelu_tanh(v[i]);
                    } else if (mode == 6) {
                        if (c0 < Z_KPE + 64) {
                            const int d0 = ((c0 - Z_KPE) >> 3) * 4;
                            const f32x4 cs = *(const f32x4*)(cosm + (size_t)row * 32 + d0), sn = *(const f32x4*)(sinm + (size_t)row * 32 + d0);
#pragma unroll
                            for (int i = 0; i < 4; ++i) { const float x1 = v[i], x2 = v[4 + i]; v[i] = x1 * cs[i] - x2 * sn[i]; v[4 + i] = x2 * cs[i] + x1 * sn[i]; }
                        }
                    }
                    *(u32x4*)(z + (size_t)row * DINP + c0) = pack8(v);
                }
                if (mode == 3 || mode == 4) { ss = quad_sum(ss); if (fq == 0) (mode == 3 ? ssq_cq : ssq_ckv)[(size_t)row * 8 + (pn & 1) * 4 + wc] = ss; }
            }
    }
};
struct EpiQ {
    static constexpr bool PERM = true;
    bf16_t* mq; const float* ssq; const float* cosm; const float* sinm;
    DI void operator()(const Acc& acc, const pg8::Unit& u, int wr, int wc, int fr, int fq) const {
#pragma unroll
        for (int ai = 0; ai < 2; ++ai)
#pragma unroll
            for (int m = 0; m < 4; ++m) {
                const int row = u.pm * 256 + ai * 128 + wr * 64 + m * 16 + fr;
                const float rs = rsqrtf(rowsum8(ssq, row, fq) * (1.f / 512.f) + EPS) * QSCALE;
#pragma unroll
                for (int bj = 0; bj < 2; ++bj) {
                    const int c0 = u.pn * 256 + bj * 128 + wc * 32 + 8 * fq;
                    float v[8];
#pragma unroll
                    for (int i = 0; i < 4; ++i) { v[i] = acc[ai][bj][m][0][i] * rs; v[4 + i] = acc[ai][bj][m][1][i] * rs; }
                    if (c0 >= 768 && c0 < 1152) {
                        const int d0 = (((c0 - 768) & 63) >> 3) * 4;
                        const f32x4 cs = *(const f32x4*)(cosm + (size_t)row * 32 + d0), sn = *(const f32x4*)(sinm + (size_t)row * 32 + d0);
#pragma unroll
                        for (int i = 0; i < 4; ++i) { const float x1 = v[i], x2 = v[4 + i]; v[i] = x1 * cs[i] - x2 * sn[i]; v[4 + i] = x2 * cs[i] + x1 * sn[i]; }
                    }
                    *(u32x4*)(mq + (size_t)row * NQ + c0) = pack8(v);
                }
            }
    }
};
struct EpiRowScale {
    static constexpr bool PERM = true;
    bf16_t* o; int ldo; const float* ssq; float inv_n;
    DI void operator()(const Acc& acc, const pg8::Unit& u, int wr, int wc, int fr, int fq) const {
#pragma unroll
        for (int ai = 0; ai < 2; ++ai)
#pragma unroll
            for (int m = 0; m < 4; ++m) {
                const int row = u.pm * 256 + ai * 128 + wr * 64 + m * 16 + fr;
                const float rs = rsqrtf(rowsum8(ssq, row, fq) * inv_n + EPS);
#pragma unroll
                for (int bj = 0; bj < 2; ++bj) {
                    const int c0 = u.pn * 256 + bj * 128 + wc * 32 + 8 * fq;
                    float v[8];
#pragma unroll
                    for (int i = 0; i < 4; ++i) { v[i] = acc[ai][bj][m][0][i] * rs; v[4 + i] = acc[ai][bj][m][1][i] * rs; }
                    *(u32x4*)(o + (size_t)row * ldo + c0) = pack8(v);
                }
            }
    }
};
struct EpiColScale {
    static constexpr bool PERM = true;
    bf16_t* o; int ldo; const float* ssq; float inv_n;
    DI void operator()(const Acc& acc, const pg8::Unit& u, int wr, int wc, int fr, int fq) const {
#pragma unroll
        for (int bj = 0; bj < 2; ++bj) {
            const int c0 = u.pn * 256 + bj * 128 + wc * 32 + 8 * fq;
            float rs[8];
#pragma unroll
            for (int i = 0; i < 8; ++i) rs[i] = rsqrtf(rowsum8_full(ssq, c0 + i) * inv_n + EPS);
#pragma unroll
            for (int ai = 0; ai < 2; ++ai)
#pragma unroll
                for (int m = 0; m < 4; ++m) {
                    const int row = u.pm * 256 + ai * 128 + wr * 64 + m * 16 + fr;
                    float v[8];
#pragma unroll
                    for (int i = 0; i < 4; ++i) { v[i] = acc[ai][bj][m][0][i] * rs[i]; v[4 + i] = acc[ai][bj][m][1][i] * rs[4 + i]; }
                    *(u32x4*)(o + (size_t)row * ldo + c0) = pack8(v);
                }
        }
    }
};
struct EpiResid {
    static constexpr bool PERM = true;
    bf16_t* xb; float* ssq_out;
    DI void operator()(const Acc& acc, const pg8::Unit& u, int wr, int wc, int fr, int fq) const {
#pragma unroll
        for (int ai = 0; ai < 2; ++ai)
#pragma unroll
            for (int m = 0; m < 4; ++m) {
                const int row = u.pm * 256 + ai * 128 + wr * 64 + m * 16 + fr;
                float ss = 0.f;
#pragma unroll
                for (int bj = 0; bj < 2; ++bj) {
                    const size_t off = (size_t)row * DM + u.pn * 256 + bj * 128 + wc * 32 + 8 * fq;
                    const u32x4 rw = *(const u32x4*)(xb + off);
                    float o[8];
                    o[0] = bflo(rw.x) + acc[ai][bj][m][0][0]; o[1] = bfhi(rw.x) + acc[ai][bj][m][0][1]; o[2] = bflo(rw.y) + acc[ai][bj][m][0][2]; o[3] = bfhi(rw.y) + acc[ai][bj][m][0][3];
                    o[4] = bflo(rw.z) + acc[ai][bj][m][1][0]; o[5] = bfhi(rw.z) + acc[ai][bj][m][1][1]; o[6] = bflo(rw.w) + acc[ai][bj][m][1][2]; o[7] = bfhi(rw.w) + acc[ai][bj][m][1][3];
                    *(u32x4*)(xb + off) = pack8(o);
#pragma unroll
                    for (int i = 0; i < 8; ++i) ss += o[i] * o[i];
                }
                ss = quad_sum(ss);
                if (fq == 0) ssq_out[(size_t)row * 32 + u.pn * 4 + wc] = ss;
            }
    }
};
struct EpiGLU {
    static constexpr bool PERM = true;
    bf16_t* hid; const float* ssq;
    DI void operator()(const Acc& acc, const pg8::Unit& u, int wr, int wc, int fr, int fq) const {
#pragma unroll
        for (int ai = 0; ai < 2; ++ai)
#pragma unroll
            for (int m = 0; m < 4; ++m) {
                const int row = u.pm * 256 + ai * 128 + wr * 64 + m * 16 + fr;
                const float rs = rsqrtf(rowsum32(ssq, row, fq) * (1.f / DM) + EPS);
                float v[8];
#pragma unroll
                for (int i = 0; i < 4; ++i) {
                    v[i] = silu(acc[ai][0][m][0][i] * rs) * (acc[ai][1][m][0][i] * rs);
                    v[4 + i] = silu(acc[ai][0][m][1][i] * rs) * (acc[ai][1][m][1][i] * rs);
                }
                *(u32x4*)(hid + (size_t)row * DFF + u.pn * 128 + wc * 32 + 8 * fq) = pack8(v);
            }
    }
};

struct ColMapIn { const float* w; DI const float* operator()(int n) const {
    if (n < 1536) { const int p = n & 127, a = p >> 3, i = p & 7; return w + (n - p) + 4 * a + (i & 3) + 64 * (i >> 2); }
    if (n < 4096) return w + n;
    if (n < 5120) return w + n + 64;
    if (n < 5184) { const int p = n - 5120, a = p >> 3, i = p & 7; return w + 4096 + 4 * a + (i & 3) + 32 * (i >> 2); }
    return nullptr; } };
struct ColMapUq { const float* w; DI const float* operator()(int n) const {
    if (n < 768) return w + (n >> 7) * 192 + (n & 127);
    if (n < 1152) { const int q = n - 768, hh = q >> 6, p = q & 63, a = p >> 3, i = p & 7; return w + hh * 192 + 128 + 4 * a + (i & 3) + 32 * (i >> 2); }
    return nullptr; } };
struct ColMapKv { const float* w; int off; DI const float* operator()(int n) const { return w + (n >> 7) * 256 + off + (n & 127); } };
struct ColMapId { const float* w; DI const float* operator()(int n) const { return w + n; } };
struct ColMapGu { const float* wg; const float* wu; DI const float* operator()(int n) const { const int t = n >> 8, r = n & 255; return r < 128 ? wg + t * 128 + r : wu + t * 128 + (r - 128); } };

template <class CM>
DI void convert_T(LAS float* tile, bf16_t* dst, int K, int Nd, int srcN, const float* gain, const CM cm, int bid, int nb, int& off) {
    const int tid = tid_opaque(), n4 = tid & 31, kk = tid >> 5;
    const int nkt = K / 64, nnt = Nd / 128, nitems = nkt * nnt;
    int it = bid - off; if (it < 0) it += nb;
    off = (off + nitems) % nb;
    constexpr int NF = 4;
    f32x4 v[NF][4];
#define CVT_LOAD(f, item_) do { const int k0_ = ((item_) / nnt) * 64, n0_ = ((item_) % nnt) * 128; const float* src_ = cm(n0_ + 4 * n4); \
        _Pragma("unroll") for (int p = 0; p < 4; ++p) { const int k_ = k0_ + kk + 16 * p; \
            if (src_) { v[f][p] = *(const f32x4*)(src_ + (size_t)k_ * srcN); if (gain) { const float g_ = gain[k_]; v[f][p] = v[f][p] * g_; } } else v[f][p] = (f32x4){0.f, 0.f, 0.f, 0.f}; } } while (0)
#define CVT_STORE(f, item_) do { const int k0_ = ((item_) / nnt) * 64, n0_ = ((item_) % nnt) * 128; \
        _Pragma("unroll") for (int p = 0; p < 4; ++p) { const int k_ = kk + 16 * p; *(LAS f32x4*)(tile + k_ * 128 + ((4 * n4) ^ (8 * ((k_ >> 3) & 3)))) = v[f][p]; } \
        __syncthreads(); \
        if ((item_) + NF * nb < nitems) CVT_LOAD(f, (item_) + NF * nb); \
        _Pragma("unroll") for (int q = 0; q < 2; ++q) { const int c = tid & 7, n = (tid >> 3) + 64 * q, nsw = n ^ (8 * (c & 3)); float o[8];     \
            _Pragma("unroll") for (int j = 0; j < 8; ++j) o[j] = tile[(8 * c + j) * 128 + nsw]; \
            *(u32x4*)(dst + (size_t)(n0_ + n) * K + k0_ + 8 * c) = pack8(o); } \
        __syncthreads(); } while (0)
#pragma unroll
    for (int f = 0; f < NF; ++f) if (it + f * nb < nitems) CVT_LOAD(f, it + f * nb);
    for (; it < nitems; it += NF * nb) {
#pragma unroll
        for (int f = 0; f < NF; ++f) if (it + f * nb < nitems) CVT_STORE(f, it + f * nb);
    }
#undef CVT_LOAD
#undef CVT_STORE
}

constexpr int T136 = 136, TILE_B = 128 * T136 * 2;
DI void mm128(const LAS unsigned char* A, const LAS unsigned char* Bt, f32x4 (&acc)[8], int w, int fr, int fq) {
#pragma unroll
    for (int ks = 0; ks < 4; ++ks) {
        const bf16x8 a = *(const LAS bf16x8*)(A + ((16 * w + fr) * T136 + 32 * ks + 8 * fq) * 2);
#pragma unroll
        for (int nb = 0; nb < 8; ++nb) {
            const bf16x8 b = *(const LAS bf16x8*)(Bt + ((16 * nb + fr) * T136 + 32 * ks + 8 * fq) * 2);
            acc[nb] = __builtin_amdgcn_mfma_f32_16x16x32_bf16(b, a, acc[nb], 0, 0, 0);
        }
    }
}
DI void stage_rows(int tid, LAS unsigned char* T, const bf16_t* g, size_t ld) {
#pragma unroll
    for (int p = 0; p < 4; ++p) { const int q = tid + 512 * p, r = q >> 4, c = q & 15; *(LAS u32x4*)(T + (r * T136 + 8 * c) * 2) = *(const u32x4*)(g + (size_t)r * ld + 8 * c); }
}
DI void tile_load(int tid, u32x4 (&v)[4], const bf16_t* g, size_t ld) {
    const int r = tid & 127;
#pragma unroll
    for (int p = 0; p < 4; ++p) v[p] = *(const u32x4*)(g + (size_t)r * ld + 8 * ((tid >> 7) + 4 * p));
}
DI void tile_store_T(int tid, LAS unsigned char* T, const u32x4 (&v)[4], const LAS float* rowscale, const float* colgain) {
    const int r = tid & 127;
    const float rs = rowscale ? rowscale[r] : 1.f;
#pragma unroll
    for (int p = 0; p < 4; ++p) {
        const int cc = (tid >> 7) + 4 * p;
        const unsigned w[4] = {v[p].x, v[p].y, v[p].z, v[p].w};
#pragma unroll
        for (int j = 0; j < 4; ++j) {
            const int c0 = 8 * cc + 2 * j;
            float a = bflo(w[j]) * rs, b = bfhi(w[j]) * rs;
            if (colgain) { a *= colgain[c0]; b *= colgain[c0 + 1]; }
            *(LAS unsigned short*)(T + ((c0) * T136 + r) * 2) = (unsigned short)f2bf(a);
            *(LAS unsigned short*)(T + ((c0 + 1) * T136 + r) * 2) = (unsigned short)f2bf(b);
        }
    }
}

DI float ret_log_gamma(int h) {
    return h == 0 ? -3.1748698315e-02f : h == 1 ? -1.5748356968e-02f : h == 2 ? -7.8431774610e-03f : h == 3 ? -3.9138993211e-03f : h == 4 ? -1.9550348358e-03f : -9.7703964783e-04f; }

DI void ret_kv_unit(LAS unsigned char* lds, int n, int h, const bf16_t* z, float* kvT) {
    const int tid = tid_opaque(), w = tid >> 6, lane = tid & 63, fr = lane & 15, fq = lane >> 4;
    LAS unsigned char* TA = lds; LAS unsigned char* TB = lds + TILE_B; LAS float* dec = (LAS float*)(lds + 2 * TILE_B);
    const float lg = ret_log_gamma(h);
    const bf16_t* zr = z + (size_t)n * 128 * DINP;
    u32x4 vv[4], kk[4];
    tile_load(tid, vv, zr + Z_RV + h * 128, DINP); tile_load(tid, kk, zr + Z_RK + h * 128, DINP);
    __syncthreads();
    if (tid < 128) dec[tid] = __expf(lg * (127.f - (float)tid));
    __syncthreads();
    tile_store_T(tid, TA, vv, nullptr, nullptr);
    tile_store_T(tid, TB, kk, dec, nullptr);
    __syncthreads();
    f32x4 acc[8];
#pragma unroll
    for (int i = 0; i < 8; ++i) acc[i] = (f32x4){0.f, 0.f, 0.f, 0.f};
    mm128(TA, TB, acc, w, fr, fq);
    float* o = kvT + ((size_t)(n * 6 + h) * 128 + 16 * w + fr) * 128 + 4 * fq;
#pragma unroll
    for (int nb = 0; nb < 8; ++nb) *(f32x4*)(o + 16 * nb) = acc[nb];
}

DI void ret_out_unit(LAS unsigned char* lds, int n, int h, const bf16_t* z, const bf16_t* prevT, const float* mixg, bf16_t* y) {
    const int tid = tid_opaque(), w = tid >> 6, lane = tid & 63, fr = lane & 15, fq = lane >> 4;
    LAS unsigned char* TQ = lds; LAS unsigned char* TK = lds + TILE_B; LAS unsigned char* TS = lds + 2 * TILE_B; LAS unsigned char* TP = lds + 3 * TILE_B;
    const float lg = ret_log_gamma(h);
    const bf16_t* zr = z + (size_t)n * 128 * DINP;
    u32x4 vv[4];
    tile_load(tid, vv, zr + Z_RV + h * 128, DINP);
    u32x2 gwv[8];
#pragma unroll
    for (int nb = 0; nb < 8; ++nb) gwv[nb] = *(const u32x2*)(zr + (size_t)(16 * w + fr) * DINP + Z_RG + h * 128 + 16 * nb + 4 * fq);
    __syncthreads();
    stage_rows(tid, TQ, zr + Z_RQ + h * 128, DINP);
    stage_rows(tid, TK, zr + Z_RK + h * 128, DINP);
    stage_rows(tid, TP, prevT + (size_t)(n * 6 + h) * 16384, 128);
    __syncthreads();
    f32x4 acc[8];
#pragma unroll
    for (int i = 0; i < 8; ++i) acc[i] = (f32x4){0.f, 0.f, 0.f, 0.f};
    mm128(TQ, TK, acc, w, fr, fq);
    const int irow = 16 * w + fr;
#pragma unroll
    for (int nb = 0; nb < 8; ++nb) {
        float v[4];
#pragma unroll
        for (int i = 0; i < 4; ++i) { const int j = 16 * nb + 4 * fq + i; const int rel = irow - j; v[i] = rel >= 0 ? acc[nb][i] * __expf(lg * (float)rel) : 0.f; }
        u32x2 wv; wv.x = pk2(v[0], v[1]); wv.y = pk2(v[2], v[3]);
        *(LAS u32x2*)(TS + (irow * T136 + 16 * nb + 4 * fq) * 2) = wv;
    }
    __syncthreads();
    tile_store_T(tid, TK, vv, nullptr, nullptr);
    __syncthreads();
    f32x4 a1[8], a2[8];
#pragma unroll
    for (int i = 0; i < 8; ++i) { a1[i] = (f32x4){0.f, 0.f, 0.f, 0.f}; a2[i] = (f32x4){0.f, 0.f, 0.f, 0.f}; }
    mm128(TS, TK, a1, w, fr, fq);
    mm128(TQ, TP, a2, w, fr, fq);
    const float qd = __expf(lg * (float)(irow + 1));
    float ss = 0.f;
#pragma unroll
    for (int nb = 0; nb < 8; ++nb)
#pragma unroll
        for (int i = 0; i < 4; ++i) { const float o = a1[nb][i] + qd * a2[nb][i]; a1[nb][i] = o; ss += o * o; }
    ss = quad_sum(ss);
    const float rs = rsqrtf(ss * (1.f / 128.f) + EPS);
    const size_t tok = (size_t)n * 128 + irow;
#pragma unroll
    for (int nb = 0; nb < 8; ++nb) {
        const int e0 = 16 * nb + 4 * fq;
        const u32x2 gw = gwv[nb];
        const f32x4 mg = *(const f32x4*)(mixg + h * 128 + e0);
        const float g0 = silu(bflo(gw.x)), g1 = silu(bfhi(gw.x)), g2 = silu(bflo(gw.y)), g3 = silu(bfhi(gw.y));
        u32x2 o; o.x = pk2(a1[nb][0] * rs * mg[0] * g0, a1[nb][1] * rs * mg[1] * g1); o.y = pk2(a1[nb][2] * rs * mg[2] * g2, a1[nb][3] * rs * mg[3] * g3);
        *(u32x2*)(y + tok * DM + h * 128 + e0) = o;
    }
}

DI void gmlp_unit(LAS unsigned char* lds, int n, int g, const bf16_t* z, const float* w_s, const float* b_s, const float* vgain, const float* mixg, bf16_t* y) {
    const int tid = tid_opaque(), w = tid >> 6, lane = tid & 63, fr = lane & 15, fq = lane >> 4;
    LAS unsigned char* TA = lds; LAS unsigned char* TB = lds + TILE_B; LAS float* part = (LAS float*)(lds + 2 * TILE_B); LAS float* rstd = part + 512;
    const bf16_t* zr = z + (size_t)n * 128 * DINP;
    __syncthreads();
    u32x4 vv[4];
    tile_load(tid, vv, zr + Z_GV + g * 128, DINP);
    {
        const int r = tid & 127; float ss = 0.f;
#pragma unroll
        for (int p = 0; p < 4; ++p) { const unsigned wv[4] = {vv[p].x, vv[p].y, vv[p].z, vv[p].w};
#pragma unroll
            for (int j = 0; j < 4; ++j) { const float a = bflo(wv[j]), b = bfhi(wv[j]); ss += a * a + b * b; } }
        part[(tid >> 7) * 128 + r] = ss;
    }
    __syncthreads();
    if (tid < 128) rstd[tid] = rsqrtf((part[tid] + part[128 + tid] + part[256 + tid] + part[384 + tid]) * (1.f / 128.f) + EPS);
    {
        const float* ws = w_s + (size_t)g * 16384;
#pragma unroll
        for (int p = 0; p < 8; ++p) { const int q = tid + 512 * p, t = q >> 5, s0 = (q & 31) * 4; const f32x4 v = *(const f32x4*)(ws + t * 128 + s0);
            u32x2 o; o.x = pk2(s0 <= t ? v[0] : 0.f, s0 + 1 <= t ? v[1] : 0.f); o.y = pk2(s0 + 2 <= t ? v[2] : 0.f, s0 + 3 <= t ? v[3] : 0.f);
            *(LAS u32x2*)(TA + (t * T136 + s0) * 2) = o; }
    }
    __syncthreads();
    tile_store_T(tid, TB, vv, rstd, vgain + g * 128);
    __syncthreads();
    f32x4 acc[8];
#pragma unroll
    for (int i = 0; i < 8; ++i) acc[i] = (f32x4){0.f, 0.f, 0.f, 0.f};
    mm128(TA, TB, acc, w, fr, fq);
    const int t = 16 * w + fr; const size_t tok = (size_t)n * 128 + t;
    const float bias = b_s[g * 128 + t];
    float ss = 0.f;
#pragma unroll
    for (int nb = 0; nb < 8; ++nb) {
        const u32x2 uw = *(const u32x2*)(z + tok * DINP + Z_GU + g * 128 + 16 * nb + 4 * fq);
        const float u0 = bflo(uw.x), u1 = bfhi(uw.x), u2 = bflo(uw.y), u3 = bfhi(uw.y);
        acc[nb][0] = u0 * (acc[nb][0] + bias); acc[nb][1] = u1 * (acc[nb][1] + bias); acc[nb][2] = u2 * (acc[nb][2] + bias); acc[nb][3] = u3 * (acc[nb][3] + bias);
        ss += (acc[nb][0] * acc[nb][0] + acc[nb][1] * acc[nb][1]) + (acc[nb][2] * acc[nb][2] + acc[nb][3] * acc[nb][3]);
    }
    ss = quad_sum(ss);
    const float rs = rsqrtf(ss * (1.f / 128.f) + EPS);
#pragma unroll
    for (int nb = 0; nb < 8; ++nb) {
        const int c0 = 1536 + g * 128 + 16 * nb + 4 * fq;
        const f32x4 mg = *(const f32x4*)(mixg + c0);
        u32x2 o; o.x = pk2(acc[nb][0] * rs * mg[0], acc[nb][1] * rs * mg[1]); o.y = pk2(acc[nb][2] * rs * mg[2], acc[nb][3] * rs * mg[3]);
        *(u32x2*)(y + tok * DM + c0) = o;
    }
}

constexpr int KSTR = 400, VSTR = 136, ABUF = 45056, AV_OFF = 25600;
__device__ const unsigned ATT_UNITS[80] = {0x8a4001fu, 0x8c8041fu, 0x8ec081fu, 0x9100c1fu, 0x4c40017u, 0x4e80417u, 0x50c0817u, 0x1e4000fu, 0x208040fu, 0x40007u, 0x823e01eu, 0x847c3feu, 0x86ba7deu, 0x88f8bbeu, 0x463e016u, 0x487c3f6u, 0x7a3c01du, 0x7c783ddu, 0x7eb479du, 0x80f0b5du, 0x4ab87d6u, 0x403c015u, 0x1a3c00eu, 0x1c783ceu, 0x723a01cu, 0x74743bcu, 0x76ae75cu, 0x78e8afcu, 0x42763d5u, 0x44b0775u, 0x6a3801bu, 0x6c7039bu, 0x6ea871bu, 0x70e0a9bu, 0x3a38014u, 0x3c70394u, 0x3ea8714u, 0x163800du, 0x187038du, 0x38006u, 0x623601au, 0x646c37au, 0x66a26dau, 0x68d8a3au, 0x3436013u, 0x366c373u, 0x5a34019u, 0x5c68359u, 0x5e9c699u, 0x60d09d9u, 0x38a06d3u, 0x2e34012u, 0x123400cu, 0x146834cu, 0x5232018u, 0x5464338u, 0x5696658u, 0x58c8978u, 0x3066352u, 0x3298672u, 0x2830011u, 0x2a60311u, 0x2c90611u, 0xe3000bu, 0x106030bu, 0x30005u, 0x222e010u, 0x245c2f0u, 0x26885d0u, 0xa2c00au, 0xc582cau, 0x628009u, 0x850289u, 0x28004u, 0x224008u, 0x448248u, 0x20003u, 0x18002u, 0x10001u, 0x8000u};
DI void attn_finish(f32x16 (&o)[4], float l, int h, int qrow, int hi, const float* mixg, bf16_t* y) {
    const float inv = __builtin_amdgcn_rcpf(l);
    float ss = 0.f;
#pragma unroll
    for (int i = 0; i < 4; ++i)
#pragma unroll
        for (int r = 0; r < 16; ++r) { const float v = o[i][r] * inv; o[i][r] = v; ss += v * v; }
    ss = half_sum(ss);
    const float rs = rsqrtf(ss * (1.f / 128.f) + EPS);
    bf16_t* yr = y + (size_t)qrow * DM + 768 + 128 * h;
    const float* mg = mixg + 768 + 128 * h;
#pragma unroll
    for (int db = 0; db < 4; ++db)
#pragma unroll
        for (int gq = 0; gq < 4; ++gq) {
            const int d0 = 32 * db + 8 * gq + 4 * hi;
            const f32x4 gg = *(const f32x4*)(mg + d0);
            u32x2 ov; ov.x = pk2(o[db][4 * gq] * rs * gg[0], o[db][4 * gq + 1] * rs * gg[1]); ov.y = pk2(o[db][4 * gq + 2] * rs * gg[2], o[db][4 * gq + 3] * rs * gg[3]);
            *(u32x2*)(yr + d0) = ov;
        }
}
DI void attn_combine_wave(const float* rec, int k, int h, int qrow0, int lane, const float* mixg, bf16_t* y) {
    const int r32 = lane & 31, hi = lane >> 5;
    float mt = -1e30f;
    for (int i = 0; i < k; ++i) mt = fmaxf(mt, rec[(size_t)i * APART_REC + 32 * 64 + lane]);
    f32x16 o[4];
#pragma unroll
    for (int i = 0; i < 4; ++i)
#pragma unroll
        for (int r = 0; r < 16; ++r) o[i][r] = 0.f;
    float lt = 0.f;
#pragma unroll 1
    for (int i = 0; i < k; ++i) {
        const float* ri = rec + (size_t)i * APART_REC; const unsigned* rw = (const unsigned*)ri;
        const float a = __builtin_amdgcn_exp2f(ri[32 * 64 + lane] - mt);
        lt += ri[33 * 64 + lane] * a;
        unsigned wv[32];
#pragma unroll
        for (int q = 0; q < 32; ++q) wv[q] = rw[q * 64 + lane];
#pragma unroll
        for (int d = 0; d < 4; ++d)
#pragma unroll
            for (int r = 0; r < 16; r += 2) { const unsigned w = wv[d * 8 + (r >> 1)]; o[d][r] += bflo(w) * a; o[d][r + 1] += bfhi(w) * a; }
    }
    attn_finish(o, lt, h, qrow0 + r32, hi, mixg, y);
}
DI void attn_unit(LAS unsigned char* lds, int h, int qb, int s_begin, int s_end, float* part, const bf16_t* mq, const bf16_t* kn, const bf16_t* z, const bf16_t* vt, const float* mixg, bf16_t* y) {
    const int tid = tid_opaque(), w = tid >> 6, lane = tid & 63, r32 = lane & 31, hi = lane >> 5;
    const int q0 = 256 * qb + 32 * w;
    bf16x8 qf[12];
    {
        const bf16_t* qr = mq + (size_t)(q0 + r32) * NQ;
#pragma unroll
        for (int ks = 0; ks < 8; ++ks) qf[ks] = *(const bf16x8*)(qr + 128 * h + 16 * ks + 8 * hi);
#pragma unroll
        for (int ks = 0; ks < 4; ++ks) qf[8 + ks] = *(const bf16x8*)(qr + 768 + 64 * h + 16 * ks + 8 * hi);
    }
    f32x16 o[4];
#pragma unroll
    for (int i = 0; i < 4; ++i)
#pragma unroll
        for (int r = 0; r < 16; ++r) o[i][r] = 0.f;
    float mrow = -1e30f, lrow = 0.f;
    u32x4 kreg[3], vreg[2];
    const bf16_t* knsrc = kn + (size_t)(tid >> 4) * NKV + 128 * h + 8 * (tid & 15);
    const bf16_t* kpsrc = z + (size_t)(tid >> 3) * DINP + Z_KPE + 8 * (tid & 7);
    const bf16_t* vsrc = vt + (size_t)(128 * h + (tid >> 3)) * S + 8 * (tid & 7);
    const int kndst = (tid >> 4) * KSTR + (tid & 15) * 16, kpdst = (tid >> 3) * KSTR + 256 + (tid & 7) * 16;
    const int vdst = AV_OFF + (tid >> 3) * VSTR + (tid & 7) * 16;
#define ATT_LOAD(step_) do { const size_t k0_ = (size_t)64 * (step_); \
        kreg[0] = *(const u32x4*)(knsrc + k0_ * NKV); kreg[1] = *(const u32x4*)(knsrc + (k0_ + 32) * NKV); kreg[2] = *(const u32x4*)(kpsrc + k0_ * DINP); \
        vreg[0] = *(const u32x4*)(vsrc + k0_); vreg[1] = *(const u32x4*)(vsrc + (size_t)64 * S + k0_); } while (0)
#define ATT_STORE(buf_) do { LAS unsigned char* b_ = lds + (buf_) * ABUF; \
        *(LAS u32x4*)(b_ + kndst) = kreg[0]; *(LAS u32x4*)(b_ + kndst + 32 * KSTR) = kreg[1]; *(LAS u32x4*)(b_ + kpdst) = kreg[2]; \
        *(LAS u32x2*)(b_ + vdst) = (u32x2){vreg[0].x, vreg[0].y}; *(LAS u32x2*)(b_ + vdst + 8) = (u32x2){vreg[0].z, vreg[0].w}; \
        *(LAS u32x2*)(b_ + vdst + 64 * VSTR) = (u32x2){vreg[1].x, vreg[1].y}; *(LAS u32x2*)(b_ + vdst + 64 * VSTR + 8) = (u32x2){vreg[1].z, vreg[1].w}; } while (0)
    ATT_LOAD(s_begin);
    ATT_STORE(0);
    if (s_begin + 1 < s_end) ATT_LOAD(s_begin + 1);
    __syncthreads();
    for (int step = s_begin; step < s_end; ++step) {
        const int cur = (step - s_begin) & 1;
        if (step + 1 < s_end) { ATT_STORE(cur ^ 1); if (step + 2 < s_end) ATT_LOAD(step + 2); }
        const int jd = step - 4 * qb;
        if (!(jd >= 0 && 64 * jd > 32 * w + 31)) {
            const LAS unsigned char* kt = lds + cur * ABUF;
            f32x16 p0, p1;
#pragma unroll
            for (int r = 0; r < 16; ++r) { p0[r] = 0.f; p1[r] = 0.f; }
            const LAS unsigned char* kb0 = kt + r32 * KSTR + 16 * hi;
            const LAS unsigned char* vb0 = kt + AV_OFF + r32 * VSTR + 8 * hi;
#define ATT_SCHED __builtin_amdgcn_sched_barrier(0)
#define KLOAD(dst, b_) do { _Pragma("unroll") for (int j = 0; j < 2; ++j) { dst[j][0] = *(const LAS bf16x8*)(kb0 + 32 * (2 * (b_) + j)); dst[j][1] = *(const LAS bf16x8*)(kb0 + 32 * KSTR + 32 * (2 * (b_) + j)); } } while (0)
#define KMMA(src, b_) do { _Pragma("unroll") for (int j = 0; j < 2; ++j) { p0 = __builtin_amdgcn_mfma_f32_32x32x16_bf16(src[j][0], qf[2 * (b_) + j], p0, 0, 0, 0); p1 = __builtin_amdgcn_mfma_f32_32x32x16_bf16(src[j][1], qf[2 * (b_) + j], p1, 0, 0, 0); } } while (0)
#define VLOAD(dst, db_) do { _Pragma("unroll") for (int kb = 0; kb < 2; ++kb) _Pragma("unroll") for (int s = 0; s < 2; ++s) { const LAS unsigned char* vp = vb0 + (db_) * 32 * VSTR + (32 * kb + 16 * s) * 2; \
                const s16x4 lo = *(const LAS s16x4*)vp, hi4 = *(const LAS s16x4*)(vp + 16); dst[2 * kb + s] = __builtin_shufflevector(lo, hi4, 0, 1, 2, 3, 4, 5, 6, 7); } } while (0)
#define VMMA(src, db_) do { _Pragma("unroll") for (int i = 0; i < 4; ++i) o[db_] = __builtin_amdgcn_mfma_f32_32x32x16_bf16(src[i], pf[i], o[db_], 0, 0, 0); } while (0)
            {
                bf16x8 kA[2][2], kB[2][2];
                KLOAD(kA, 0); ATT_SCHED;
                KLOAD(kB, 1); ATT_SCHED; KMMA(kA, 0); ATT_SCHED;
                KLOAD(kA, 2); ATT_SCHED; KMMA(kB, 1); ATT_SCHED;
                KLOAD(kB, 3); ATT_SCHED; KMMA(kA, 2); ATT_SCHED;
                KLOAD(kA, 4); ATT_SCHED; KMMA(kB, 3); ATT_SCHED;
                KLOAD(kB, 5); ATT_SCHED; KMMA(kA, 4); ATT_SCHED;
                KMMA(kB, 5); ATT_SCHED;
            }
            bf16x8 vA[4], vB[4];
            VLOAD(vA, 0); ATT_SCHED;
            if (jd >= 0) {
                const int qrel = 32 * w + r32;
#pragma unroll
                for (int r = 0; r < 16; ++r) { const int kr = 64 * jd + (r & 3) + 8 * (r >> 2) + 4 * hi; if (kr > qrel) p0[r] = -INFINITY; if (kr + 32 > qrel) p1[r] = -INFINITY; }
            }
            float mx = fmaxf(p0[0], p1[0]), mx2 = fmaxf(p0[1], p1[1]);
#pragma unroll
            for (int r = 2; r < 16; r += 2) { mx = max3f(mx, p0[r], p1[r]); mx2 = max3f(mx2, p0[r + 1], p1[r + 1]); }
            mx = fmaxf(mx, mx2);
            mx = half_max(mx);
            if (__any(mx > mrow + 8.f)) {
                const float mnew = fmaxf(mrow, mx);
                const float alpha = __builtin_amdgcn_exp2f(mrow - mnew);
                lrow *= alpha; mrow = mnew;
#pragma unroll
                for (int i = 0; i < 4; ++i)
#pragma unroll
                    for (int r = 0; r < 16; ++r) o[i][r] *= alpha;
            }
            float ls = 0.f;
#pragma unroll
            for (int r = 0; r < 16; ++r) { p0[r] = __builtin_amdgcn_exp2f(p0[r] - mrow); p1[r] = __builtin_amdgcn_exp2f(p1[r] - mrow); ls += p0[r] + p1[r]; }
            lrow += ls;
            bf16x8 pf[4];
#pragma unroll
            for (int s = 0; s < 2; ++s) {
                u32x4 a, b;
                a.x = pk2(p0[8 * s + 0], p0[8 * s + 1]); a.y = pk2(p0[8 * s + 2], p0[8 * s + 3]); a.z = pk2(p0[8 * s + 4], p0[8 * s + 5]); a.w = pk2(p0[8 * s + 6], p0[8 * s + 7]);
                b.x = pk2(p1[8 * s + 0], p1[8 * s + 1]); b.y = pk2(p1[8 * s + 2], p1[8 * s + 3]); b.z = pk2(p1[8 * s + 4], p1[8 * s + 5]); b.w = pk2(p1[8 * s + 6], p1[8 * s + 7]);
                pf[s] = __builtin_bit_cast(bf16x8, a); pf[2 + s] = __builtin_bit_cast(bf16x8, b);
            }
            ATT_SCHED;
            VLOAD(vB, 1); ATT_SCHED; VMMA(vA, 0); ATT_SCHED;
            VLOAD(vA, 2); ATT_SCHED; VMMA(vB, 1); ATT_SCHED;
            VLOAD(vB, 3); ATT_SCHED; VMMA(vA, 2); ATT_SCHED;
            VMMA(vB, 3); ATT_SCHED;
#undef KLOAD
#undef KMMA
#undef VLOAD
#undef VMMA
#undef ATT_SCHED
        }
        __syncthreads();
    }
#undef ATT_LOAD
#undef ATT_STORE
    lrow = half_sum(lrow);
    if (part) {
        float* rec = part + (size_t)w * 34 * 64; unsigned* rw = (unsigned*)rec;
#pragma unroll
        for (int i = 0; i < 4; ++i)
#pragma unroll
            for (int r = 0; r < 16; r += 2) rw[(i * 8 + (r >> 1)) * 64 + lane] = pk2(o[i][r], o[i][r + 1]);
        rec[32 * 64 + lane] = mrow; rec[33 * 64 + lane] = lrow;
    } else attn_finish(o, lrow, h, q0 + r32, hi, mixg, y);
}

#define XB_TMO      128
#define XB_XCNT(j)  (256  + 64 * (j))
#define XB_XSUB(j)  (1280 + 64 * (j))
#define XB_XGEN(j)  (2304 + 64 * (j))
#define XB_TOP      3328
#define XB_TOPGEN   3392
#define XCD_BAR_WORDS 3456
#define XB_SPIN_CAP (1u << 20)
DI unsigned xb_ld(unsigned* p)              { return __hip_atomic_load(p, __ATOMIC_RELAXED, __HIP_MEMORY_SCOPE_AGENT); }
DI unsigned xb_add(unsigned* p, unsigned v) { return __hip_atomic_fetch_add(p, v, __ATOMIC_RELAXED, __HIP_MEMORY_SCOPE_AGENT); }
DI unsigned xb_xcc_id() { return (unsigned)__builtin_amdgcn_s_getreg((3 << 11) | 20) & 0xFu; }
#define XB_SPIN(cond, bar) do { unsigned _sp = 0; while (cond) { __builtin_amdgcn_s_sleep(1); \
    if ((++_sp & 255u) == 0u) { if (xb_ld(&(bar)[XB_TMO])) break; if (_sp > XB_SPIN_CAP) { atomicAdd(&(bar)[XB_TMO], 1u); break; } } } } while (0)
struct XcdBarrier { unsigned* bar; unsigned x; volatile LAS unsigned* st; };
DI XcdBarrier xcd_barrier_post(unsigned* bar, volatile LAS unsigned* st) {
    XcdBarrier b; b.bar = bar; b.x = xb_xcc_id(); b.st = st;
    if (threadIdx.x == 0) (void)xb_add(&bar[XB_XCNT(b.x)], 1u);
    return b;
}
DI void xcd_barrier_complete(unsigned* bar, unsigned x, unsigned& nloc, unsigned& nx) {
    const unsigned G = gridDim.x * gridDim.y * gridDim.z;
    unsigned sum, cnt, mine, sp = 0u;
    for (;;) {
        sum = 0u; cnt = 0u; mine = 0u;
#pragma unroll
        for (unsigned j = 0; j < 16; ++j) { const unsigned c = xb_ld(&bar[XB_XCNT(j)]); sum += c; cnt += (c > 0u) ? 1u : 0u; mine = (j == x) ? c : mine; }
        if (sum == G) break;
        __builtin_amdgcn_s_sleep(1);
        if ((++sp & 255u) == 0u) { if (xb_ld(&bar[XB_TMO])) break; if (sp > XB_SPIN_CAP) { atomicAdd(&bar[XB_TMO], 1u); break; } }
    }
    nloc = mine > 0u ? mine : 1u; nx = cnt > 0u ? cnt : 1u;
}
DI void xcd_barrier(const XcdBarrier& b) {
    asm volatile("s_waitcnt vmcnt(0)" ::: "memory");
    __syncthreads();
    if (threadIdx.x == 0) {
        unsigned* bar = b.bar;
        __builtin_amdgcn_s_waitcnt(0);
        unsigned nloc = b.st[0], nx = b.st[1];
        if (nloc == 0u) { xcd_barrier_complete(bar, b.x, nloc, nx); b.st[0] = nloc; b.st[1] = nx; }
        const unsigned old = xb_add(&bar[XB_XSUB(b.x)], 1u);
        const unsigned gen = old / nloc;
        if (old + 1u == (gen + 1u) * nloc) {
            __builtin_amdgcn_fence(__ATOMIC_RELEASE, "agent");
            asm volatile("s_waitcnt vmcnt(0)" ::: "memory");
            const unsigned og = xb_add(&bar[XB_TOP], 1u);
            const unsigned tg = og / nx;
            if (og + 1u == (tg + 1u) * nx) xb_add(&bar[XB_TOPGEN], 1u);
            else XB_SPIN(xb_ld(&bar[XB_TOPGEN]) == tg, bar);
            __builtin_amdgcn_fence(__ATOMIC_ACQUIRE, "agent");
            xb_add(&bar[XB_XGEN(b.x)], 1u);
            asm volatile("s_waitcnt vmcnt(0)" ::: "memory");
        } else {
            asm volatile("buffer_inv sc1" ::: "memory");
            XB_SPIN(xb_ld(&bar[XB_XGEN(b.x)]) == gen, bar);
            asm volatile("s_waitcnt vmcnt(0)" ::: "memory");
        }
    }
    __syncthreads();
}

typedef const Params __attribute__((address_space(4))) CParams;
DI CParams* params_opaque() { unsigned long long p = (unsigned long long)__builtin_amdgcn_kernarg_segment_ptr(); asm volatile("" : "+s"(p)); return (CParams*)p; }
#define WSPTR(T, off) ((T*)(ws + (off)))

DI void phase_prologue(LAS unsigned char* lds) {
    CParams* P = params_opaque();
    const int tid = tid_opaque(), bid = blockIdx.x, G = gridDim.x, wave = tid >> 6, lane = tid & 63;
    unsigned char* ws = P->ws;
    float* pattn = WSPTR(float, WS_PATTN);
    {
        const float* x = P->x; bf16_t* xb = WSPTR(bf16_t, WS_XB);
        for (int row = bid * 8 + wave; row < S; row += G * 8) {
            const float* xr = x + (size_t)row * DM; float ss = 0.f;
#pragma unroll
            for (int j = 0; j < 8; ++j) { const f32x4 v = *(const f32x4*)(xr + 4 * lane + 256 * j); ss += (v[0] * v[0] + v[1] * v[1]) + (v[2] * v[2] + v[3] * v[3]);
                u32x2 o; o.x = pk2(v[0], v[1]); o.y = pk2(v[2], v[3]); *(u32x2*)(xb + (size_t)row * DM + 4 * lane + 256 * j) = o; }
#pragma unroll
            for (int o = 1; o < 64; o <<= 1) ss += __shfl_xor(ss, o);
            if (lane < 32) pattn[(size_t)row * 32 + lane] = lane == 0 ? ss : 0.f;
        }
    }
    LAS float* tile = (LAS float*)lds;
    int off = 0;
#pragma unroll 1
    for (int l = 0; l < NL; ++l) {
        unsigned char* wl = ws + WS_W + (size_t)l * W_LAYER;
        convert_T(tile, (bf16_t*)(wl + WO_IN), DM, DINP, DIN, P->attn_norm + l * DM, ColMapIn{P->w_in + (size_t)l * DM * DIN}, bid, G, off);
        convert_T(tile, (bf16_t*)(wl + WO_UQ), 512, NQ, 1152, P->q_norm + l * 512, ColMapUq{P->w_uq + (size_t)l * 512 * 1152}, bid, G, off);
        convert_T(tile, (bf16_t*)(wl + WO_K), 512, 768, 1536, P->kv_norm + l * 512, ColMapKv{P->w_ukv + (size_t)l * 512 * 1536, 0}, bid, G, off);
        convert_T(tile, (bf16_t*)(wl + WO_V), 512, 768, 1536, P->kv_norm + l * 512, ColMapKv{P->w_ukv + (size_t)l * 512 * 1536, 128}, bid, G, off);
        convert_T(tile, (bf16_t*)(wl + WO_OUT), DM, DM, DM, nullptr, ColMapId{P->w_out + (size_t)l * DM * DM}, bid, G, off);
        convert_T(tile, (bf16_t*)(wl + WO_GU), DM, 2 * DFF, DFF, P->ffn_norm + l * DM, ColMapGu{P->w_gate + (size_t)l * DM * DFF, P->w_up + (size_t)l * DM * DFF}, bid, G, off);
        convert_T(tile, (bf16_t*)(wl + WO_DN), DFF, DM, DM, nullptr, ColMapId{P->w_down + (size_t)l * DFF * DM}, bid, G, off);
    }
    {
        float* cosr = WSPTR(float, WS_COSR); float* sinr = WSPTR(float, WS_SINR); float* cosm = WSPTR(float, WS_COSM); float* sinm = WSPTR(float, WS_SINM);
        const int* pos = P->pos;
        for (int i = bid * 512 + tid; i < S * 96; i += G * 512) {
            const int s = i / 96, j = i % 96;
            const float ps = (float)pos[s];
            float inv; if (j < 64) inv = 1.0f / powf(10000.f, (float)(2 * j) / 128.f); else inv = 1.0f / powf(10000.f, (float)(2 * (j - 64)) / 64.f);
            const float ang = ps * inv;
            const double a = (double)ang; const double nrev = rint(a * 0.15915494309189535); const float red = (float)(a - nrev * 6.283185307179586);
            const float c = cosf(red), sn = sinf(red);
            if (j < 64) { cosr[s * 64 + j] = c; sinr[s * 64 + j] = sn; } else { cosm[s * 32 + j - 64] = c; sinm[s * 32 + j - 64] = sn; }
        }
    }
}

DI void phase_A(LAS unsigned char* lds, int l) {
    CParams* P = params_opaque(); unsigned char* ws = P->ws; const int bid = blockIdx.x, G = gridDim.x;
    pg8::Gemm g{WSPTR(bf16_t, WS_XB), (const bf16_t*)(ws + WS_W + (size_t)l * W_LAYER + WO_IN), S, DINP, DM, DM, DM}; pg8::StaticOrder so; so.init(S, DINP, G, bid);
    EpiIn E{WSPTR(bf16_t, WS_Z), WSPTR(float, WS_PATTN), WSPTR(float, WS_PCQ), WSPTR(float, WS_PCKV), WSPTR(float, WS_COSR), WSPTR(float, WS_SINR), WSPTR(float, WS_COSM), WSPTR(float, WS_SINM)};
    pg8::gemm_phase(lds, g, so, E);
}
DI void phase_B1(LAS unsigned char* lds, int l) {
    CParams* P = params_opaque(); unsigned char* ws = P->ws; const int bid = blockIdx.x, G = gridDim.x;
    float* ssq_cq = WSPTR(float, WS_PCQ);
    pg8::Gemm g{WSPTR(bf16_t, WS_Z) + Z_CQ, (const bf16_t*)(ws + WS_W + (size_t)l * W_LAYER + WO_UQ), S, NQ, 512, DINP, 512}; pg8::StaticOrder so; so.init(S, NQ, G, bid);
    EpiQ E{WSPTR(bf16_t, WS_MQ), ssq_cq, WSPTR(float, WS_COSM), WSPTR(float, WS_SINM)}; pg8::gemm_phase(lds, g, so, E);
}
DI void phase_B2(LAS unsigned char* lds, int l) {
    CParams* P = params_opaque(); unsigned char* ws = P->ws; const int bid = blockIdx.x, G = gridDim.x;
    float* ssq_ckv = WSPTR(float, WS_PCKV);
    pg8::Gemm g{WSPTR(bf16_t, WS_Z) + Z_CKV, (const bf16_t*)(ws + WS_W + (size_t)l * W_LAYER + WO_K), S, NKV, 512, DINP, 512}; pg8::StaticOrder so; so.init(S, NKV, G, (bid + 64) % G);
    EpiRowScale E{WSPTR(bf16_t, WS_KN), NKV, ssq_ckv, 1.f / 512.f}; pg8::gemm_phase(lds, g, so, E);
}
DI void phase_B3(LAS unsigned char* lds, int l) {
    CParams* P = params_opaque(); unsigned char* ws = P->ws; const int bid = blockIdx.x, G = gridDim.x;
    float* ssq_ckv = WSPTR(float, WS_PCKV);
    pg8::Gemm g{(const bf16_t*)(ws + WS_W + (size_t)l * W_LAYER + WO_V), WSPTR(bf16_t, WS_Z) + Z_CKV, NKV, S, 512, 512, DINP}; pg8::StaticOrder so; so.init(NKV, S, G, (bid + 128) % G);
    EpiColScale E{WSPTR(bf16_t, WS_VT), S, ssq_ckv, 1.f / 512.f}; pg8::gemm_phase(lds, g, so, E);
}
DI void phase_B4(LAS unsigned char* lds, int l) {
    CParams* P = params_opaque(); unsigned char* ws = P->ws;
    volatile LAS unsigned* slot = (volatile LAS unsigned*)(lds + LDS_BYTES - 8);
    unsigned* counter = (unsigned*)(ws + WS_SSQ) + 3840 + l * 64;
    for (;;) {
        __syncthreads();
        if (threadIdx.x == 0) *slot = atomicAdd(counter, 1u);
        __syncthreads();
        const int u = (int)*slot;
        if (u >= 640) break;
        if (u < 384) ret_kv_unit(lds, u / 6, u % 6, WSPTR(bf16_t, WS_Z), WSPTR(float, WS_KVT));
        else { const int v = u - 384; gmlp_unit(lds, v >> 2, v & 3, WSPTR(bf16_t, WS_Z), P->w_s + (size_t)l * 4 * 16384, P->b_s + l * 512, P->gv_norm + l * 512, P->mix_norm + l * DM, WSPTR(bf16_t, WS_Y)); }
    }
}
DI void phase_C(LAS unsigned char* lds, int l) {
    CParams* P = params_opaque(); unsigned char* ws = P->ws; const int bid = blockIdx.x, G = gridDim.x;
    {
        const int tid = tid_opaque(); const float* kvT = WSPTR(float, WS_KVT); bf16_t* prevT = WSPTR(bf16_t, WS_PREVT);
        for (int e = bid * 512 + tid; e < 6 * 16384; e += G * 512) {
            const int h = e >> 14, ed = e & 16383;
            const float decay = __expf(ret_log_gamma(h) * 128.f);
            float st = 0.f;
            for (int n = 0; n < 64; ++n) { const size_t idx = ((size_t)(n * 6 + h) << 14) + ed; prevT[idx] = (bf16_t)f2bf(st); st = decay * st + kvT[idx]; }
        }
    }
    {
        volatile LAS unsigned* slot = (volatile LAS unsigned*)(lds + LDS_BYTES - 8);
        unsigned* counter = (unsigned*)(ws + WS_SSQ) + 3584 + l * 64;
        float* apart = WSPTR(float, WS_APART);
        for (;;) {
            __syncthreads();
            if (threadIdx.x == 0) *slot = atomicAdd(counter, 1u);
            __syncthreads();
            const int u = (int)*slot;
            if (u >= 480) break;
            const int h = u % 6; const unsigned e = ATT_UNITS[u / 6];
            const int qb = e & 31, s0 = (e >> 5) & 255, s1 = (e >> 13) & 255, rec = (int)(e >> 21);
            float* part = rec ? apart + (size_t)(h * 72 + rec - 1) * APART_REC : nullptr;
            attn_unit(lds, h, qb, s0, s1, part, WSPTR(bf16_t, WS_MQ), WSPTR(bf16_t, WS_KN), WSPTR(bf16_t, WS_Z), WSPTR(bf16_t, WS_VT), P->mix_norm + l * DM, WSPTR(bf16_t, WS_Y));
        }
    }
}
DI void phase_D(LAS unsigned char* lds, int l) {
    CParams* P = params_opaque(); unsigned char* ws = P->ws; const int bid = blockIdx.x, G = gridDim.x;
    {
        const int tid = tid_opaque(), gw = bid * 8 + (tid >> 6), lane = tid & 63; const float* apart = WSPTR(float, WS_APART);
        const int nw = G * 8, gsh = (gw + nw - (nw >> 1)) % nw;
        for (int j = gsh; j < 1152; j += nw) { const int w = j & 7, t = j >> 3, h = t / 24, qb = 8 + t % 24, k = (qb + 8) >> 3;
            const int base = qb < 16 ? (qb - 8) * 2 : qb < 24 ? 16 + (qb - 16) * 3 : 40 + (qb - 24) * 4;
            attn_combine_wave(apart + (size_t)(h * 72 + base) * APART_REC + (size_t)w * 34 * 64, k, h, 256 * qb + 32 * w, lane, P->mix_norm + l * DM, WSPTR(bf16_t, WS_Y)); }
    }
    for (int u = bid; u < 384; u += G) ret_out_unit(lds, u / 6, u % 6, WSPTR(bf16_t, WS_Z), WSPTR(bf16_t, WS_PREVT), P->mix_norm + l * DM, WSPTR(bf16_t, WS_Y));
}
DI void phase_E(LAS unsigned char* lds, int l) {
    CParams* P = params_opaque(); unsigned char* ws = P->ws; const int bid = blockIdx.x, G = gridDim.x;
    pg8::Gemm g{WSPTR(bf16_t, WS_Y), (const bf16_t*)(ws + WS_W + (size_t)l * W_LAYER + WO_OUT), S, DM, DM, DM, DM}; pg8::StaticOrder so; so.init(S, DM, G, bid);
    EpiResid E{WSPTR(bf16_t, WS_XB), WSPTR(float, WS_PFFN)};
    pg8::gemm_phase(lds, g, so, E);
}
DI void phase_F(LAS unsigned char* lds, int l) {
    CParams* P = params_opaque(); unsigned char* ws = P->ws; const int bid = blockIdx.x, G = gridDim.x;
    pg8::Gemm g{WSPTR(bf16_t, WS_XB), (const bf16_t*)(ws + WS_W + (size_t)l * W_LAYER + WO_GU), S, 2 * DFF, DM, DM, DM}; pg8::StaticOrder so; so.init(S, 2 * DFF, G, bid);
    EpiGLU E{WSPTR(bf16_t, WS_HID), WSPTR(float, WS_PFFN)};
    pg8::gemm_phase(lds, g, so, E);
}
DI void phase_G(LAS unsigned char* lds, int l) {
    CParams* P = params_opaque(); unsigned char* ws = P->ws; const int bid = blockIdx.x, G = gridDim.x;
    pg8::Gemm g{WSPTR(bf16_t, WS_HID), (const bf16_t*)(ws + WS_W + (size_t)l * W_LAYER + WO_DN), S, DM, DFF, DFF, DFF}; pg8::StaticOrder so; so.init(S, DM, G, bid);
    EpiResid E{WSPTR(bf16_t, WS_XB), WSPTR(float, WS_PATTN)};
    pg8::gemm_phase(lds, g, so, E);
}
DI void phase_final() {
    CParams* P = params_opaque(); unsigned char* ws = P->ws; const int bid = blockIdx.x, G = gridDim.x;
    const int tid = tid_opaque(), wave = tid >> 6, lane = tid & 63;
    const float* sf = WSPTR(float, WS_PATTN); const bf16_t* xb = WSPTR(bf16_t, WS_XB); const float* fn = P->final_norm; float* out = P->out;
    for (int row = bid * 8 + wave; row < S; row += G * 8) {
        float tot = sf[(size_t)row * 32 + (lane & 31)];
#pragma unroll
        for (int o = 1; o < 32; o <<= 1) tot += __shfl_xor(tot, o);
        const float rs = rsqrtf(tot * (1.f / DM) + EPS);
#pragma unroll
        for (int j = 0; j < 8; ++j) { const int c = 4 * lane + 256 * j; const u32x2 v = *(const u32x2*)(xb + (size_t)row * DM + c); const f32x4 gn = *(const f32x4*)(fn + c);
            f32x4 o; o[0] = bflo(v.x) * rs * gn[0]; o[1] = bfhi(v.x) * rs * gn[1]; o[2] = bflo(v.y) * rs * gn[2]; o[3] = bfhi(v.y) * rs * gn[3];
            *(f32x4*)(out + (size_t)row * DM + c) = o; }
    }
}

__global__ void __launch_bounds__(512, 2) fwd_megakernel(Params Pbyval) {
    extern __shared__ __attribute__((aligned(16))) unsigned char smem[];
    LAS unsigned char* lds = (LAS unsigned char*)smem;
    cg::grid_group grid = cg::this_grid();
    volatile LAS unsigned* bst = (volatile LAS unsigned*)(lds + LDS_BYTES - 16);
    if (threadIdx.x < 4) bst[threadIdx.x] = 0u;
    __syncthreads();
    if (blockIdx.x == 0) { CParams* P = params_opaque(); unsigned* cw = (unsigned*)(P->ws + WS_SSQ);
        for (int i = threadIdx.x; i < 4096; i += 512) cw[i] = 0u; }
#define GSYNC() do { CParams* Pb_ = params_opaque(); XcdBarrier b_; b_.bar = (unsigned*)(Pb_->ws + WS_SSQ); b_.x = xb_xcc_id(); b_.st = (volatile LAS unsigned*)(lds + LDS_BYTES - 16); xcd_barrier(b_); } while (0)
    phase_prologue(lds);
    asm volatile("s_waitcnt vmcnt(0) lgkmcnt(0)" ::: "memory"); grid.sync();
    { CParams* P = params_opaque(); (void)xcd_barrier_post((unsigned*)(P->ws + WS_SSQ), bst); }
#pragma unroll 1
    for (int l = 0; l < NL; ++l) {
        phase_A(lds, l);
        GSYNC();
        phase_B1(lds, l); phase_B2(lds, l); phase_B3(lds, l); phase_B4(lds, l);
        GSYNC();
        phase_C(lds, l);
        GSYNC();
        phase_D(lds, l);
        GSYNC();
        phase_E(lds, l);
        GSYNC();
        phase_F(lds, l);
        GSYNC();
        phase_G(lds, l);
        GSYNC();
    }
    phase_final();
}

extern "C" void kernel_launch(void* const* d_in, const int* in_sizes, int n_in, void* d_out, int out_size, void* d_ws, size_t ws_size, hipStream_t stream) {
    static int grid_blocks = 0;
    if (grid_blocks == 0) {
        if (n_in != 18 || out_size != S * DM || ws_size < WS_END) { fprintf(stderr, "kernel_launch: unexpected problem (n_in %d out %d ws %zu need %zu)\n", n_in, out_size, ws_size, (size_t)WS_END); grid_blocks = -1; return; }
        int dev = 0, cus = 0, per_cu = 0;
        hipGetDevice(&dev);
        hipDeviceGetAttribute(&cus, hipDeviceAttributeMultiprocessorCount, dev);
        hipFuncSetAttribute((const void*)fwd_megakernel, hipFuncAttributeMaxDynamicSharedMemorySize, LDS_BYTES);
        hipOccupancyMaxActiveBlocksPerMultiprocessor(&per_cu, (const void*)fwd_megakernel, 512, LDS_BYTES);
        if (per_cu < 1) { fprintf(stderr, "kernel_launch: occupancy query returned %d\n", per_cu); per_cu = 1; }
        grid_blocks = cus * per_cu;
    }
    if (grid_blocks < 0) return;
    Params p{};
    p.x = (const float*)d_in[0]; p.pos = (const int*)d_in[1]; p.attn_norm = (const float*)d_in[2]; p.w_in = (const float*)d_in[3]; p.q_norm = (const float*)d_in[4];
    p.w_uq = (const float*)d_in[5]; p.kv_norm = (const float*)d_in[6]; p.w_ukv = (const float*)d_in[7]; p.gv_norm = (const float*)d_in[8]; p.w_s = (const float*)d_in[9];
    p.b_s = (const float*)d_in[10]; p.mix_norm = (const float*)d_in[11]; p.w_out = (const float*)d_in[12]; p.ffn_norm = (const float*)d_in[13]; p.w_gate = (const float*)d_in[14];
    p.w_up = (const float*)d_in[15]; p.w_down = (const float*)d_in[16]; p.final_norm = (const float*)d_in[17]; p.out = (float*)d_out; p.ws = (unsigned char*)d_ws;
    void* args[] = {&p};
    hipError_t e = hipLaunchCooperativeKernel((const void*)fwd_megakernel, dim3(grid_blocks), dim3(512), args, LDS_BYTES, stream);
    if (e != hipSuccess) fprintf(stderr, "cooperative launch failed: %s (grid %d)\n", hipGetErrorString(e), grid_blocks);
}
```
